# Optimizing an MI355X kernel written in HIP

```python
import jax
import jax.numpy as jnp
from jax import lax
import numpy as np

D_MODEL = 1024
BATCH = 32
SEQ = 2048
DEPTH = 2

GM_W = 512
GM_GROUPS = 4
GM_CHUNK = 128
ML_H = 4
ML_DH = 128
ML_W = ML_H * ML_DH
ML_CHUNK = 64
CONV_K = 4
NSA_H = 8
NSA_G = 2
NSA_R = NSA_H // NSA_G
NSA_DH = 64
NSA_W = NSA_H * NSA_DH
NSA_KV = NSA_G * NSA_DH
NSA_NB = 3
CMP_BLOCK = 32
CMP_STRIDE = 16
SEL_BLOCK = 64
TOP_N = 8
WINDOW = 512
NSA_QC = 32
N_BRANCH = 3
D_FF = 4 * D_MODEL
EPS = 1e-6
NEG = -1e30
BIG = 1e4
F32 = jnp.float32
SPLIT_SIZES = (GM_W, GM_W, ML_W, ML_W, ML_W, ML_W, ML_H, ML_H, NSA_W, NSA_KV, NSA_KV, NSA_KV, NSA_KV, NSA_KV, NSA_KV, NSA_H * NSA_NB, D_MODEL, D_MODEL, D_MODEL)
P_TOTAL = sum(SPLIT_SIZES)

kernel_name = 'hybrid_gmlp_mlstm_nsa_block'


def rms_norm(x, g):
    x32 = x.astype(F32)
    y = x32 * lax.rsqrt(jnp.mean(x32 * x32, axis=-1, keepdims=True) + EPS)
    return (y * g.astype(F32)).astype(x.dtype)


def layer_norm(x, g, b):
    x32 = x.astype(F32)
    mu = jnp.mean(x32, axis=-1, keepdims=True)
    var = jnp.mean(jnp.square(x32 - mu), axis=-1, keepdims=True)
    return ((x32 - mu) * lax.rsqrt(var + EPS) * g.astype(F32) + b.astype(F32)).astype(x.dtype)


def causal_conv(x, w, b):
    S = x.shape[1]
    xp = jnp.pad(x, ((0, 0), (CONV_K - 1, 0), (0, 0)))
    y = b
    for j in range(CONV_K):
        y = y + xp[:, j:j + S] * w[j]
    return y


def gmlp_mixer(u_pre, v_pre, ln_g, ln_b, ws, bs):
    B, S, _ = u_pre.shape
    u = jax.nn.gelu(u_pre)
    v = layer_norm(jax.nn.gelu(v_pre), ln_g, ln_b)
    dg = GM_W // GM_GROUPS
    v = v.reshape(B, S // GM_CHUNK, GM_CHUNK, GM_GROUPS, dg)
    w = ws * jnp.tril(jnp.ones((GM_CHUNK, GM_CHUNK), ws.dtype))
    mixed = jnp.einsum('gts,bcsgd->bctgd', w, v) + bs.T[:, :, None]
    return u * mixed.reshape(B, S, GM_W)


def mlstm_chunk_step(carry, xs):
    c_mat, n_vec, m_prev = carry
    q, k, v, ig, lf = xs
    L = q.shape[2]
    tril = jnp.tril(jnp.ones((L, L), dtype=bool))
    b = jnp.cumsum(lf, axis=-1)
    a = b + m_prev[..., None]
    d = jnp.where(tril, b[..., :, None] - b[..., None, :] + ig[..., None, :], -jnp.inf)
    m = jnp.maximum(a, jnp.max(d, axis=-1))
    w_inter = jnp.exp(a - m)
    s = jnp.einsum('bhtd,bhsd->bhts', q, k) * jnp.exp(d - m[..., None])
    num = jnp.einsum('bhts,bhse->bhte', s, v) + w_inter[..., None] * jnp.einsum('bhed,bhtd->bhte', c_mat, q)
    den = jnp.sum(s, axis=-1) + w_inter * jnp.einsum('bhd,bhtd->bht', n_vec, q)
    h = num / jnp.maximum(jnp.abs(den), jnp.exp(-m))[..., None]
    m_last = m[..., -1]
    w_prev = jnp.exp(a[..., -1] - m_last)
    w_s = jnp.exp(b[..., -1:] - b + ig - m_last[..., None])
    c_new = w_prev[..., None, None] * c_mat + jnp.einsum('bhs,bhse,bhsd->bhed', w_s, v, k)
    n_new = w_prev[..., None] * n_vec + jnp.einsum('bhs,bhsd->bhd', w_s, k)
    return (c_new, n_new, m_last), h


def mlstm_mixer(q, k, v, o_pre, i_pre, f_pre, conv_w, conv_b, gate_b, norm_g):
    B, S, _ = v.shape
    dtype = v.dtype
    qk = jax.nn.silu(causal_conv(jnp.concatenate([q, k], axis=-1), conv_w, conv_b))
    q, k = jnp.split(qk, 2, axis=-1)
    nc = S // ML_CHUNK

    def heads(t):
        return t.astype(F32).reshape(B, nc, ML_CHUNK, ML_H, ML_DH).transpose(1, 0, 3, 2, 4)

    def gate_heads(t):
        return t.reshape(B, nc, ML_CHUNK, ML_H).transpose(1, 0, 3, 2)

    qh = heads(q)
    kh = heads(k) * (ML_DH ** -0.5)
    vh = heads(v)
    ig = gate_heads((i_pre + gate_b[:ML_H]).astype(F32))
    lf = gate_heads(jax.nn.log_sigmoid((f_pre + gate_b[ML_H:]).astype(F32)))
    init = (jnp.zeros((B, ML_H, ML_DH, ML_DH), F32), jnp.zeros((B, ML_H, ML_DH), F32), jnp.zeros((B, ML_H), F32))
    _, h = lax.scan(mlstm_chunk_step, init, (qh, kh, vh, ig, lf))
    h = h.transpose(1, 0, 3, 2, 4).reshape(B, S, ML_H, ML_DH)
    mu = jnp.mean(h, axis=-1, keepdims=True)
    var = jnp.mean(jnp.square(h - mu), axis=-1, keepdims=True)
    hn = (h - mu) * lax.rsqrt(var + EPS) * norm_g.astype(F32).reshape(ML_H, ML_DH)
    return (jax.nn.sigmoid(o_pre.astype(F32)) * hn.reshape(B, S, ML_W)).astype(dtype)


def compress_blocks(kv, pe, w1, w2):
    B, S, G, dh = kv.shape
    n_cmp = (S - CMP_BLOCK) // CMP_STRIDE + 1
    idx = jnp.arange(n_cmp)[:, None] * CMP_STRIDE + jnp.arange(CMP_BLOCK)[None, :]
    blocks = kv[:, idx] + pe[:, None, :]
    blocks = blocks.transpose(0, 3, 1, 2, 4).reshape(B, G, n_cmp, CMP_BLOCK * dh)
    return jax.nn.gelu(blocks @ w1) @ w2


def masked_softmax(s, valid, axis=-1):
    p = jax.nn.softmax(jnp.where(valid, s, NEG), axis=axis)
    return jnp.where(valid, p, 0.0)


def nsa_mixer(q, kc, vc, ks, vs, kw, vw, gates, pe_k, pe_v, phi_k1, phi_k2, phi_v1, phi_v2):
    B, S, _ = q.shape
    dtype = q.dtype
    qh = q.reshape(B, S, NSA_G, NSA_R, NSA_DH).transpose(0, 2, 3, 1, 4)

    def kv_heads(t):
        return t.reshape(B, S, NSA_G, NSA_DH)

    k_cmp = compress_blocks(kv_heads(kc), pe_k, phi_k1, phi_k2)
    v_cmp = compress_blocks(kv_heads(vc), pe_v, phi_v1, phi_v2).astype(F32)
    n_cmp = k_cmp.shape[2]
    cmp_start = jnp.arange(n_cmp) * CMP_STRIDE
    cmp_end = cmp_start + CMP_BLOCK - 1
    cmp_center = cmp_start.astype(F32) + (CMP_BLOCK - 1) * 0.5
    n_sel = S // SEL_BLOCK
    top_n = min(TOP_N, n_sel)
    sel = jnp.arange(n_sel)
    overlap = ((cmp_start[:, None] <= sel[None, :] * SEL_BLOCK + SEL_BLOCK - 1) & (cmp_end[:, None] >= sel[None, :] * SEL_BLOCK)).astype(F32)
    k_sel = kv_heads(ks).transpose(0, 2, 1, 3).reshape(B, NSA_G, n_sel, SEL_BLOCK, NSA_DH)
    v_sel = kv_heads(vs).transpose(0, 2, 1, 3).reshape(B, NSA_G, n_sel, SEL_BLOCK, NSA_DH)
    pad = ((0, 0), (0, 0), (WINDOW, 0), (0, 0))
    k_win = jnp.pad(kv_heads(kw).transpose(0, 2, 1, 3), pad)
    v_win = jnp.pad(kv_heads(vw).transpose(0, 2, 1, 3), pad)
    g = jax.nn.sigmoid(gates.astype(F32)).reshape(B, S, NSA_G, NSA_R, NSA_NB).transpose(0, 2, 3, 1, 4)
    slopes = (2.0 ** (-8.0 * (jnp.arange(NSA_H, dtype=F32) + 1.0) / NSA_H)).reshape(NSA_G, NSA_R)
    scale = NSA_DH ** -0.5
    bi = jnp.arange(B)[:, None, None, None]
    gi = jnp.arange(NSA_G)[None, :, None, None]

    def query_chunk(qi):
        t0 = qi * NSA_QC
        qb = lax.dynamic_slice_in_dim(qh, t0, NSA_QC, axis=3)
        t = t0 + jnp.arange(NSA_QC)
        tf = t.astype(F32)
        sc = jnp.einsum('bgrqd,bgcd->bgrqc', qb, k_cmp).astype(F32) * scale - slopes[:, :, None, None] * (tf[:, None] - cmp_center[None, :])
        p_c = masked_softmax(sc, cmp_end[None, :] <= t[:, None])
        o_cmp = jnp.einsum('bgrqc,bgcd->bgrqd', p_c, v_cmp)
        imp = jnp.einsum('bgrqc,cj->bgqj', p_c, overlap)
        jt = (t // SEL_BLOCK)[:, None]
        forced = (sel == 0) | (sel == jt) | (sel == jt - 1)
        imp = jnp.where(sel > jt, NEG, jnp.where(forced, BIG, imp))
        _, idx = lax.top_k(imp, top_n)
        kg = k_sel[bi, gi, idx]
        vg = v_sel[bi, gi, idx].astype(F32)
        s_pos = idx[..., None] * SEL_BLOCK + jnp.arange(SEL_BLOCK)
        dist_s = (tf[:, None, None] - s_pos.astype(F32))[:, :, None]
        ss = jnp.einsum('bgrqd,bgqnld->bgrqnl', qb, kg).astype(F32) * scale - slopes[:, :, None, None, None] * dist_s
        p_s = masked_softmax(ss, (s_pos <= t[:, None, None])[:, :, None], axis=(-2, -1))
        o_sel = jnp.einsum('bgrqnl,bgqnld->bgrqd', p_s, vg)
        kwb = lax.dynamic_slice_in_dim(k_win, t0, WINDOW + NSA_QC, axis=2)
        vwb = lax.dynamic_slice_in_dim(v_win, t0, WINDOW + NSA_QC, axis=2).astype(F32)
        pos = t0 - WINDOW + jnp.arange(WINDOW + NSA_QC)
        sw = jnp.einsum('bgrqd,bgkd->bgrqk', qb, kwb).astype(F32) * scale - slopes[:, :, None, None] * (tf[:, None] - pos.astype(F32)[None, :])
        valid_w = (pos[None, :] >= 0) & (pos[None, :] <= t[:, None]) & (t[:, None] - pos[None, :] < WINDOW)
        o_win = jnp.einsum('bgrqk,bgkd->bgrqd', masked_softmax(sw, valid_w), vwb)
        gb = lax.dynamic_slice_in_dim(g, t0, NSA_QC, axis=3)
        return gb[..., 0:1] * o_cmp + gb[..., 1:2] * o_sel + gb[..., 2:3] * o_win

    out = lax.map(query_chunk, jnp.arange(S // NSA_QC))
    return out.transpose(1, 0, 4, 2, 3, 5).reshape(B, S, NSA_W).astype(dtype)


def hybrid_mixer(h, w_in, gm_ln_g, gm_ln_b, gm_ws, gm_bs, ml_conv_w, ml_conv_b, ml_gate_b, ml_norm_g,
                 nsa_pe_k, nsa_pe_v, nsa_phi_k1, nsa_phi_k2, nsa_phi_v1, nsa_phi_v2, w_up_a, w_up_b, w_up_c, w_out):
    z = h @ w_in
    (gu, gv, mq, mk, mv, mo, mi, mf, nq, nkc, nvc, nks, nvs, nkw, nvw, ngate, ga, gbr, gc) = jnp.split(
        z, np.cumsum(SPLIT_SIZES)[:-1].tolist(), axis=-1)
    y_a = gmlp_mixer(gu, gv, gm_ln_g, gm_ln_b, gm_ws, gm_bs) @ w_up_a
    y_b = mlstm_mixer(mq, mk, mv, mo, mi, mf, ml_conv_w, ml_conv_b, ml_gate_b, ml_norm_g) @ w_up_b
    y_c = nsa_mixer(nq, nkc, nvc, nks, nvs, nkw, nvw, ngate, nsa_pe_k, nsa_pe_v,
                    nsa_phi_k1, nsa_phi_k2, nsa_phi_v1, nsa_phi_v2) @ w_up_c
    merged = jax.nn.sigmoid(ga) * y_a + jax.nn.sigmoid(gbr) * y_b + jax.nn.sigmoid(gc) * y_c
    return merged @ w_out


def setup_inputs(seed: int = 0) -> dict:
    key = jax.random.key(seed)
    ks = jax.random.split(key, 40)
    L = DEPTH

    def nrm(k, shape, scale):
        return scale * jax.random.normal(k, shape, F32)

    ml_gate_b = jnp.concatenate([nrm(ks[12], (L, ML_H), 0.1),
                                 jnp.linspace(3.0, 6.0, ML_H, dtype=F32)[None, :] + nrm(ks[13], (L, ML_H), 0.1)], axis=-1)
    return {
        'x': nrm(ks[0], (BATCH, SEQ, D_MODEL), 1.0),
        'c': nrm(ks[1], (BATCH, D_MODEL), 1.0),
        'g_norm1': 1.0 + nrm(ks[2], (L, D_MODEL), 0.02),
        'g_norm2': 1.0 + nrm(ks[3], (L, D_MODEL), 0.02),
        'w_ada': nrm(ks[4], (L, D_MODEL, 6 * D_MODEL), 0.3 * D_MODEL ** -0.5),
        'b_ada': nrm(ks[5], (L, 6 * D_MODEL), 0.02),
        'w_in': nrm(ks[6], (L, D_MODEL, P_TOTAL), D_MODEL ** -0.5),
        'gm_ln_g': 1.0 + nrm(ks[7], (L, GM_W), 0.02),
        'gm_ln_b': nrm(ks[8], (L, GM_W), 0.02),
        'gm_ws': nrm(ks[9], (L, GM_GROUPS, GM_CHUNK, GM_CHUNK), GM_CHUNK ** -0.5),
        'gm_bs': 1.0 + nrm(ks[10], (L, GM_GROUPS, GM_CHUNK), 0.1),
        'ml_conv_w': nrm(ks[11], (L, CONV_K, 2 * ML_W), CONV_K ** -0.5),
        'ml_conv_b': nrm(ks[14], (L, 2 * ML_W), 0.02),
        'ml_gate_b': ml_gate_b,
        'ml_norm_g': 1.0 + nrm(ks[15], (L, ML_W), 0.02),
        'nsa_pe_k': nrm(ks[16], (L, CMP_BLOCK, NSA_DH), 0.1),
        'nsa_pe_v': nrm(ks[17], (L, CMP_BLOCK, NSA_DH), 0.1),
        'nsa_phi_k1': nrm(ks[18], (L, CMP_BLOCK * NSA_DH, NSA_DH), (CMP_BLOCK * NSA_DH) ** -0.5),
        'nsa_phi_k2': nrm(ks[19], (L, NSA_DH, NSA_DH), NSA_DH ** -0.5),
        'nsa_phi_v1': nrm(ks[20], (L, CMP_BLOCK * NSA_DH, NSA_DH), (CMP_BLOCK * NSA_DH) ** -0.5),
        'nsa_phi_v2': nrm(ks[21], (L, NSA_DH, NSA_DH), NSA_DH ** -0.5),
        'w_up_a': nrm(ks[22], (L, GM_W, D_MODEL), GM_W ** -0.5),
        'w_up_b': nrm(ks[23], (L, ML_W, D_MODEL), ML_W ** -0.5),
        'w_up_c': nrm(ks[24], (L, NSA_W, D_MODEL), NSA_W ** -0.5),
        'w_out': nrm(ks[25], (L, D_MODEL, D_MODEL), D_MODEL ** -0.5),
        'w_mlp1': nrm(ks[26], (L, D_MODEL, D_FF), D_MODEL ** -0.5),
        'w_mlp2': nrm(ks[27], (L, D_FF, D_MODEL), D_FF ** -0.5),
        'g_final': 1.0 + nrm(ks[28], (D_MODEL,), 0.02),
    }


def reference(x, c, g_norm1, g_norm2, w_ada, b_ada, w_in, gm_ln_g, gm_ln_b, gm_ws, gm_bs,
              ml_conv_w, ml_conv_b, ml_gate_b, ml_norm_g, nsa_pe_k, nsa_pe_v, nsa_phi_k1, nsa_phi_k2,
              nsa_phi_v1, nsa_phi_v2, w_up_a, w_up_b, w_up_c, w_out, w_mlp1, w_mlp2, g_final):
    cond = jax.nn.silu(c)
    for l in range(DEPTH):
        mod = (cond @ w_ada[l] + b_ada[l])[:, None, :]
        sh1, sc1, gt1, sh2, sc2, gt2 = jnp.split(mod, 6, axis=-1)
        h = rms_norm(x, g_norm1[l]) * (1.0 + sc1) + sh1
        x = x + gt1 * hybrid_mixer(h, w_in[l], gm_ln_g[l], gm_ln_b[l], gm_ws[l], gm_bs[l],
                                   ml_conv_w[l], ml_conv_b[l], ml_gate_b[l], ml_norm_g[l],
                                   nsa_pe_k[l], nsa_pe_v[l], nsa_phi_k1[l], nsa_phi_k2[l],
                                   nsa_phi_v1[l], nsa_phi_v2[l], w_up_a[l], w_up_b[l], w_up_c[l], w_out[l])
        h = rms_norm(x, g_norm2[l]) * (1.0 + sc2) + sh2
        x = x + gt2 * (jnp.square(jax.nn.relu(h @ w_mlp1[l])) @ w_mlp2[l])
    return rms_norm(x, g_final)
```

```cpp
#define GSPLIT 4
#define EPI_SB 0
#include <hip/hip_runtime.h>
#include <hip/hip_cooperative_groups.h>
#include <cstdio>
#include <cstdint>
namespace cg = cooperative_groups;
namespace pg8 {
#define PG8_LAS __attribute__((address_space(3)))
typedef unsigned short bf16_t;
typedef short bf16x8 __attribute__((ext_vector_type(8)));
typedef float f32x4 __attribute__((ext_vector_type(4)));
typedef unsigned u32x4 __attribute__((ext_vector_type(4)));
constexpr int BM = 256, BK = 64, HALF = 128, HTB = HALF * BK * 2  , STAGE_BYTES = 8 * HTB, NXCD = 8, WGM = 8;

__host__ __device__ __forceinline__ int lds_byte(int r, int c) { const int st = (r >> 4) * 2 + (c >> 5), rr = r & 15, cc = c & 31, ob = rr * 64 + cc * 2; return st * 1024 + (ob ^ (((ob >> 9) & 1) << 5)); }
__host__ __device__ __forceinline__ void stage_rc(int b, int& R, int& C) { const int st = b / 1024, sb = b % 1024, swz = sb ^ (((sb >> 9) & 1) << 5); R = (st >> 1) * 16 + swz / 64; C = (st & 1) * 32 + (swz % 64) / 2; }
__host__ __device__ __forceinline__ int perm32(int rho) { const int n = rho >> 4, i = rho & 15; return 8 * (i >> 2) + 4 * n + (i & 3); }

struct Unit { int pm, pn; };
struct Gemm { const bf16_t* A; const bf16_t* Bt; int M, N, K; };

struct StaticOrder {
    int nM, nN, nwg, G, c;
    __host__ __device__ void init(int M, int N, int G_, int c_) { nM = M / BM; nN = N / BM; nwg = nM * nN; G = G_; c = c_; }
    __host__ __device__ bool next(int i, Unit& u) const {
        const long L = (long)i * G + c; if (L >= nwg) return false;
        int wgid = (int)L; { const int q = nwg / NXCD, r = nwg % NXCD, xcd = wgid % NXCD, off = wgid / NXCD; wgid = (xcd < r ? xcd * (q + 1) : r * (q + 1) + (xcd - r) * q) + off; }
        const int nig = WGM * nN, gid = wgid / nig, fm = gid * WGM, gsz = (nM - fm) < WGM ? (nM - fm) : WGM;
        u.pm = fm + ((wgid % nig) % gsz); u.pn = (wgid % nig) / gsz; return true;
    }
    __device__ __forceinline__ void a_ready(const Unit&) const {}
    __device__ __forceinline__ void done(const Unit&) const {}
};

__device__ __forceinline__ unsigned cvt_pk_bf16(float lo, float hi) { unsigned r; asm volatile("v_cvt_pk_bf16_f32 %0, %1, %2" : "=v"(r) : "v"(lo), "v"(hi)); return r; }
template <class Epi, class Sched, bool ALIGN_EPI = false, bool SP2 = false>
__device__ __forceinline__ void gemm_phase(PG8_LAS unsigned char* lds, const Gemm g, const Sched& S, const Epi& E, int wv_) {
    int lane; asm volatile("v_mbcnt_lo_u32_b32 %0, -1, 0\n\tv_mbcnt_hi_u32_b32 %0, -1, %0" : "=v"(lane)); const int wid = wv_, tid = wv_ * 64 + lane, wr = wid >> 2, wc = wid & 3, fr = lane & 15, fq = lane >> 4;
    const int K = g.K, nt = K / BK;
    unsigned voffA[2], voffB[2];
#pragma unroll
    for (int i = 0; i < 2; ++i) { int R, C; stage_rc(tid * 16 + i * 8192, R, C); const int Rb = Epi::PERM ? ((R & ~31) + perm32(R & 31)) : R;
        voffA[i] = (unsigned)(R * K + C) * 2u; voffB[i] = (unsigned)(Rb * K + C) * 2u; }
    const size_t kstep = (size_t)(BK * 2);
    const size_t hstep = (size_t)HALF * K * 2;
    const size_t tstep = 2 * hstep;
    const unsigned ldsw = (unsigned)wid * 1024u;
    const int aoff = lds_byte(wr * 64 + fr, fq * 8), boff = lds_byte(wc * 32 + fr, fq * 8);
#define PG8_SA(b, h) (((b) * 2 + (h)) * HTB)
#define PG8_SB(b, h) ((4 + (b) * 2 + (h)) * HTB)
#define PG8_STAGE(bufoff, gbase, voff) do { _Pragma("unroll") for (int _i = 0; _i < 2; ++_i) \
        __builtin_amdgcn_global_load_lds((const unsigned*)((const char*)(gbase) + (voff)[_i]), (PG8_LAS unsigned*)(lds + (bufoff) + ldsw + _i * 8192), 16, 0, 0); } while (0)
#define PG8_LDA(dst, b, h) do { _Pragma("unroll") for (int m = 0; m < 4; ++m) _Pragma("unroll") for (int k = 0; k < 2; ++k) dst[m][k] = *(const PG8_LAS bf16x8*)(lds + PG8_SA(b, h) + aoff + m * 2048 + k * 1024); } while (0)
#define PG8_LDB(dst, b, h) do { _Pragma("unroll") for (int n = 0; n < 2; ++n) _Pragma("unroll") for (int k = 0; k < 2; ++k) dst[n][k] = *(const PG8_LAS bf16x8*)(lds + PG8_SB(b, h) + boff + n * 2048 + k * 1024); } while (0)
#define PG8_MMA(ai, bj, At, Bt) do { __builtin_amdgcn_s_setprio(1); _Pragma("unroll") for (int m = 0; m < 4; ++m) _Pragma("unroll") for (int n = 0; n < 2; ++n) _Pragma("unroll") for (int k = 0; k < 2; ++k) \
        acc[ai][bj][m][n] = __builtin_amdgcn_mfma_f32_16x16x32_bf16(Bt[n][k], At[m][k], acc[ai][bj][m][n], 0, 0, 0); __builtin_amdgcn_s_setprio(0); } while (0)
#define PG8_WAIT_V(n) asm volatile("s_waitcnt vmcnt(" #n ")" ::: "memory")
#define PG8_WAIT_L(n) asm volatile("s_waitcnt lgkmcnt(" #n ")" ::: "memory")
#define PG8_BAR __builtin_amdgcn_s_barrier()
#define PG8_SCHED __builtin_amdgcn_sched_barrier(0)
    Unit cur, nxt; int ui = 0;
    if (!S.next(0, cur)) return;
    f32x4 acc[2][2][4][2];
#pragma unroll
    for (int a = 0; a < 2; ++a)
#pragma unroll
        for (int b = 0; b < 2; ++b)
#pragma unroll
            for (int m = 0; m < 4; ++m)
#pragma unroll
                for (int n = 0; n < 2; ++n) acc[a][b][m][n] = (f32x4){0.f, 0.f, 0.f, 0.f};
    bf16x8 At[4][2], B0[2][2], B1[2][2];
    const char* cA = (const char*)g.A + (size_t)cur.pm * tstep; const char* cB = (const char*)g.Bt + (size_t)cur.pn * tstep;
    S.a_ready(cur);
    if constexpr (SP2) {
        PG8_STAGE(PG8_SB(0, 0), cB, voffB); PG8_STAGE(PG8_SB(0, 1), cB + hstep, voffB); PG8_STAGE(PG8_SA(0, 0), cA, voffA); PG8_STAGE(PG8_SA(0, 1), cA + hstep, voffA);
        if (wr == 1) PG8_BAR;
        PG8_WAIT_V(2); PG8_BAR;
        PG8_STAGE(PG8_SB(1, 0), cB + kstep, voffB); PG8_STAGE(PG8_SA(1, 0), cA + kstep, voffA); PG8_STAGE(PG8_SB(1, 1), cB + hstep + kstep, voffB);
        PG8_WAIT_V(6); PG8_BAR;
    } else {
        PG8_STAGE(PG8_SB(0, 0), cB, voffB); PG8_STAGE(PG8_SA(0, 0), cA, voffA); PG8_STAGE(PG8_SB(0, 1), cB + hstep, voffB); PG8_STAGE(PG8_SA(0, 1), cA + hstep, voffA);
        if (wr == 1) PG8_BAR;
        PG8_WAIT_V(4); PG8_BAR;
        PG8_STAGE(PG8_SB(1, 0), cB + kstep, voffB); PG8_STAGE(PG8_SA(1, 0), cA + kstep, voffA); PG8_STAGE(PG8_SB(1, 1), cB + hstep + kstep, voffB);
        PG8_WAIT_V(6); PG8_BAR;
    }
    for (;;) {
        const bool has_next = S.next(ui + 1, nxt);
        const char* nA = has_next ? (const char*)g.A + (size_t)nxt.pm * tstep : cA; const char* nB = has_next ? (const char*)g.Bt + (size_t)nxt.pn * tstep : cB;
        for (int t = 0; t < nt; t += 2) {
            const bool last = (t == nt - 2);
            const char* a1 = cA + (size_t)(t + 1) * kstep;
            const char* a2 = last ? nA : cA + (size_t)(t + 2) * kstep; const char* b2 = last ? nB : cB + (size_t)(t + 2) * kstep;
            const char* a3 = a2 + kstep; const char* b3 = b2 + kstep;
            if (last && has_next) S.a_ready(nxt);
            if constexpr (SP2) {
            PG8_LDB(B0, 0, 0); PG8_LDB(B1, 0, 1); PG8_SCHED; PG8_LDA(At, 0, 0); PG8_STAGE(PG8_SA(1, 1), a1 + hstep, voffA);
            PG8_WAIT_V(8); PG8_WAIT_L(0); PG8_BAR; PG8_MMA(0, 0, At, B0); PG8_MMA(0, 1, At, B1); PG8_BAR; PG8_SCHED;
            PG8_LDA(At, 0, 1); PG8_STAGE(PG8_SB(0, 0), b2, voffB); PG8_STAGE(PG8_SB(0, 1), b2 + hstep, voffB); PG8_STAGE(PG8_SA(0, 0), a2, voffA);
            PG8_WAIT_V(8); PG8_WAIT_L(0); PG8_BAR; PG8_MMA(1, 0, At, B0); PG8_MMA(1, 1, At, B1); PG8_BAR; PG8_SCHED;
            PG8_LDB(B0, 1, 0); PG8_LDB(B1, 1, 1); PG8_SCHED; PG8_LDA(At, 1, 0); PG8_STAGE(PG8_SA(0, 1), a2 + hstep, voffA);
            PG8_WAIT_V(8); PG8_WAIT_L(0); PG8_BAR; PG8_MMA(0, 0, At, B0); PG8_MMA(0, 1, At, B1); PG8_BAR; PG8_SCHED;
            PG8_LDA(At, 1, 1); PG8_STAGE(PG8_SB(1, 0), b3, voffB); PG8_STAGE(PG8_SB(1, 1), b3 + hstep, voffB); PG8_STAGE(PG8_SA(1, 0), a3, voffA);
            PG8_WAIT_V(8); PG8_WAIT_L(0); PG8_BAR; PG8_MMA(1, 0, At, B0); PG8_MMA(1, 1, At, B1); PG8_BAR; PG8_SCHED;
            } else {
            PG8_LDB(B0, 0, 0); PG8_SCHED; PG8_LDA(At, 0, 0); PG8_STAGE(PG8_SA(1, 1), a1 + hstep, voffA);
            PG8_WAIT_L(8); PG8_BAR; PG8_WAIT_L(0); PG8_MMA(0, 0, At, B0); PG8_BAR; PG8_SCHED;
            PG8_LDB(B1, 0, 1); PG8_STAGE(PG8_SB(0, 0), b2, voffB);
            PG8_BAR; PG8_WAIT_L(0); PG8_MMA(0, 1, At, B1); PG8_BAR;
            PG8_LDA(At, 0, 1); PG8_STAGE(PG8_SA(0, 0), a2, voffA);
            PG8_BAR; PG8_WAIT_L(0); PG8_MMA(1, 0, At, B0); PG8_BAR; PG8_SCHED;
            PG8_STAGE(PG8_SB(0, 1), b2 + hstep, voffB);
            PG8_WAIT_V(6); PG8_BAR; PG8_MMA(1, 1, At, B1); PG8_BAR;
            PG8_LDB(B0, 1, 0); PG8_SCHED; PG8_LDA(At, 1, 0); PG8_STAGE(PG8_SA(0, 1), a2 + hstep, voffA);
            PG8_WAIT_L(8); PG8_BAR; PG8_WAIT_L(0); PG8_MMA(0, 0, At, B0); PG8_BAR; PG8_SCHED;
            PG8_LDB(B1, 1, 1); PG8_STAGE(PG8_SB(1, 0), b3, voffB);
            PG8_BAR; PG8_WAIT_L(0); PG8_MMA(0, 1, At, B1); PG8_BAR;
            PG8_LDA(At, 1, 1); PG8_STAGE(PG8_SA(1, 0), a3, voffA);
            PG8_BAR; PG8_WAIT_L(0); PG8_MMA(1, 0, At, B0); PG8_BAR; PG8_SCHED;
            PG8_STAGE(PG8_SB(1, 1), b3 + hstep, voffB);
            PG8_WAIT_V(6); PG8_BAR; PG8_MMA(1, 1, At, B1); PG8_BAR;
            }
        }
        if constexpr (ALIGN_EPI) { if (wr == 0) PG8_BAR; }
        if constexpr (!Epi::AFTER_DRAIN) { E(acc, cur, wr, wc, fr, fq); S.done(cur); }
        if (!has_next) break;
#pragma unroll
        for (int a = 0; a < 2; ++a)
#pragma unroll
            for (int b = 0; b < 2; ++b)
#pragma unroll
                for (int m = 0; m < 4; ++m)
#pragma unroll
                    for (int n = 0; n < 2; ++n) acc[a][b][m][n] = (f32x4){0.f, 0.f, 0.f, 0.f};
        cur = nxt; cA = nA; cB = nB; ++ui;
        if constexpr (ALIGN_EPI) { if (wr == 1) PG8_BAR; }
    }
    PG8_WAIT_V(0);
    if constexpr (!ALIGN_EPI) { if (wr == 0) PG8_BAR; }
    PG8_BAR;
    if constexpr (Epi::AFTER_DRAIN) { E.fused(acc, cur, wr, wc, fr, fq, lds, wid, lane); S.done(cur); }
#undef PG8_SA
#undef PG8_SB
#undef PG8_STAGE
#undef PG8_LDA
#undef PG8_LDB
#undef PG8_MMA
#undef PG8_WAIT_V
#undef PG8_WAIT_L
#undef PG8_BAR
#undef PG8_SCHED
}
}
using pg8::bf16_t; using pg8::bf16x8; using pg8::f32x4; using pg8::u32x4;
typedef unsigned u32x2 __attribute__((ext_vector_type(2)));
typedef float f32x2v __attribute__((ext_vector_type(2)));

constexpr int T = 65536, DM = 1024, SEQ = 2048, NB = 32;
constexpr size_t MiB = 1u << 20;
constexpr size_t WS_MOD = 1 * MiB;
constexpr size_t WS_BIAS1 = 3 * MiB;
constexpr size_t WS_KCMP = 4 * MiB;
constexpr size_t WS_VCMP = 6 * MiB;
constexpr size_t WS_W = 8 * MiB;
constexpr size_t W_LAYER = 37 * MiB;
constexpr size_t WO_IN = 0, WO_UPA = 15 * MiB, WO_UPB = 16 * MiB, WO_UPC = 17 * MiB, WO_OUT = 18 * MiB, WO_M1 = 20 * MiB, WO_M2 = 28 * MiB,
                 WO_PK1 = 36 * MiB, WO_PV1 = 36 * MiB + 256 * 1024, WO_PK2 = 36 * MiB + 512 * 1024, WO_PV2 = 36 * MiB + 520 * 1024;
constexpr size_t WS_H = 82 * MiB;
constexpr size_t WS_Z = 210 * MiB;
constexpr size_t ZSLOT = 64 * MiB;
constexpr size_t WS_NK = 658 * MiB;
constexpr size_t NKSLOT = 16 * MiB;
constexpr size_t WS_SM = 754 * MiB;
constexpr size_t WS_GAB = 762 * MiB;
constexpr size_t WS_GC = WS_Z + 5 * ZSLOT;
constexpr size_t WS_MRG = WS_Z + 3 * ZSLOT;
constexpr size_t WS_F = WS_Z;
constexpr size_t WS_END = 1018 * MiB;
constexpr int LDS_BYTES = 135168;
constexpr int NPHASE = 20;

struct KP { const float* in[28]; float* out; unsigned char* ws; int lo, hi; };

typedef __bf16 bf16x2_hw __attribute__((ext_vector_type(2)));
__device__ __forceinline__ unsigned pk2(float lo, float hi) { const f32x2v v = {lo, hi}; const bf16x2_hw b = __builtin_convertvector(v, bf16x2_hw); return __builtin_bit_cast(unsigned, b); }
__device__ __forceinline__ unsigned f2bf(float f) { return pk2(f, f) & 0xffffu; }
__device__ __forceinline__ float bf_lo(unsigned u) { return __builtin_bit_cast(float, u << 16); }
__device__ __forceinline__ float bf_hi(unsigned u) { return __builtin_bit_cast(float, u & 0xffff0000u); }
__device__ __forceinline__ float bf1(bf16_t h) { return __builtin_bit_cast(float, ((unsigned)h) << 16); }
__device__ __forceinline__ float sigm(float x) { return __builtin_amdgcn_rcpf(1.f + __builtin_amdgcn_exp2f(-1.4426950408889634f * x)); }
__device__ __forceinline__ float gelu_t(float x) { const float x2 = x * x, u = x * __builtin_fmaf(x2, -0.10294324f, -2.3022082f); return x * __builtin_amdgcn_rcpf(1.f + __builtin_amdgcn_exp2f(u)); }
__device__ __forceinline__ float silu_(float x) { return x * __builtin_amdgcn_rcpf(1.f + __builtin_amdgcn_exp2f(-1.4426950408889634f * x)); }
__device__ __forceinline__ float wave_sum(float v) {
#pragma unroll
    for (int o = 1; o < 64; o <<= 1) v += __shfl_xor(v, o);
    return v;
}
__device__ __forceinline__ float wave_max(float v) {
#pragma unroll
    for (int o = 1; o < 64; o <<= 1) v = fmaxf(v, __shfl_xor(v, o));
    return v;
}
__device__ __forceinline__ bf16x8 ld8(const bf16_t* p) { return *(const bf16x8*)p; }
__device__ __forceinline__ bf16x8 ld44(const bf16_t* p0, const bf16_t* p1) { const u32x2 a = *(const u32x2*)p0, b = *(const u32x2*)p1; const u32x4 r = {a.x, a.y, b.x, b.y}; return __builtin_bit_cast(bf16x8, r); }
__device__ __forceinline__ bf16x8 pack8(f32x4 a, f32x4 b) { const u32x4 r = {pk2(a.x, a.y), pk2(a.z, a.w), pk2(b.x, b.y), pk2(b.z, b.w)}; return __builtin_bit_cast(bf16x8, r); }
__device__ __forceinline__ int lane_id_v() { int l; asm volatile("v_mbcnt_lo_u32_b32 %0, -1, 0\n\tv_mbcnt_hi_u32_b32 %0, -1, %0" : "=v"(l)); return l; }
constexpr int TAB_OFF = 132096;
__device__ __forceinline__ const float* ldsptr(int k) { extern __shared__ __attribute__((aligned(16))) unsigned char g_lds[];
    int koff = k * 8; asm volatile("" : "+v"(koff));
    const unsigned long long v = *(const unsigned long long*)(g_lds + TAB_OFF + koff);
    const unsigned lo = __builtin_amdgcn_readfirstlane((unsigned)v), hi = __builtin_amdgcn_readfirstlane((unsigned)(v >> 32));
    return (const float*)(((unsigned long long)hi << 32) | lo); }
#define PIN(k) ldsptr(k)
#define POUT() ((float*)ldsptr(28))
#define PWS() ((unsigned char*)ldsptr(29))
__device__ __forceinline__ void grid_bar(unsigned* cnt, unsigned target) {
    __threadfence(); __syncthreads();
    if (threadIdx.x == 0) {
        __hip_atomic_fetch_add(cnt, 1u, __ATOMIC_RELEASE, __HIP_MEMORY_SCOPE_AGENT);
        while (__hip_atomic_load(cnt, __ATOMIC_ACQUIRE, __HIP_MEMORY_SCOPE_AGENT) < target) __builtin_amdgcn_s_sleep(1);
    }
    __syncthreads(); __threadfence();
}
__device__ __forceinline__ float fq_max(float v) { v = fmaxf(v, __shfl_xor(v, 16)); return fmaxf(v, __shfl_xor(v, 32)); }
__device__ __forceinline__ float fq_sum(float v) { v += __shfl_xor(v, 16); return v + __shfl_xor(v, 32); }
__device__ __forceinline__ unsigned fq_or(unsigned u) { u |= __shfl_xor(u, 16); return u | __shfl_xor(u, 32); }
#define MFMA16(a, b, c) __builtin_amdgcn_mfma_f32_16x16x32_bf16((a), (b), (c), 0, 0, 0)

#ifndef EPI_SB
#define EPI_SB 1
#endif
struct PanelOrder {
    int pm, n;
    __device__ __forceinline__ bool next(int i, pg8::Unit& u) const { if (i >= n) return false; u.pm = pm; u.pn = i; return true; }
    __device__ __forceinline__ void a_ready(const pg8::Unit&) const {}
    __device__ __forceinline__ void done(const pg8::Unit&) const {}
};
struct EpiIn {
    static constexpr bool PERM = true, AFTER_DRAIN = false;
    bf16_t* Z; bf16_t* NK; float* SM;
    __device__ __forceinline__ void operator()(const f32x4 (&acc)[2][2][4][2], const pg8::Unit& u, int wr, int wc, int fr, int fq) const {
        const int pn = u.pn, row0 = u.pm * 256 + wr * 64 + fr, cl = wc * 32 + 8 * fq;
        if (pn < 14) {
            const int slot = (0x2146530 >> (4 * (pn >> 1))) & 7;
            bf16_t* base = Z + (size_t)slot * ((size_t)T * 512) + (pn & 1) * 256 + cl;
            const bool act = pn < 4;
#pragma unroll
            for (int ai = 0; ai < 2; ++ai)
#pragma unroll
                for (int m = 0; m < 4; ++m) { bf16_t* rowp = base + (size_t)(row0 + ai * 128 + m * 16) * 512;
#pragma unroll
                    for (int bj = 0; bj < 2; ++bj) { f32x4 v0 = acc[ai][bj][m][0], v1 = acc[ai][bj][m][1];
                        if (act) { v0 = (f32x4){gelu_t(v0.x), gelu_t(v0.y), gelu_t(v0.z), gelu_t(v0.w)}; v1 = (f32x4){gelu_t(v1.x), gelu_t(v1.y), gelu_t(v1.z), gelu_t(v1.w)}; }
                        u32x4 w; w.x = pk2(v0.x, v0.y); w.y = pk2(v0.z, v0.w); w.z = pk2(v1.x, v1.y); w.w = pk2(v1.z, v1.w);
                        *(u32x4*)(rowp + bj * 128) = w; } }
        } else if (pn < 17) {
            if (pn > 14) {
                bf16_t* vt = NK + (size_t)((pn - 14) * 2 + 1) * ((size_t)T * 128) + (size_t)(cl >> 6) * 64 * 2048 + (size_t)(cl & 63) * 2048;
#pragma unroll
                for (int ai = 0; ai < 2; ++ai)
#pragma unroll
                    for (int m = 0; m < 4; ++m) { const int r = row0 + ai * 128 + m * 16; bf16_t* q = vt + (size_t)(r >> 11) * (2 * 64 * 2048) + (r & 2047);
                        const f32x4 v0 = acc[ai][1][m][0], v1 = acc[ai][1][m][1];
                        q[0 * 2048] = (bf16_t)f2bf(v0.x); q[1 * 2048] = (bf16_t)f2bf(v0.y); q[2 * 2048] = (bf16_t)f2bf(v0.z); q[3 * 2048] = (bf16_t)f2bf(v0.w);
                        q[4 * 2048] = (bf16_t)f2bf(v1.x); q[5 * 2048] = (bf16_t)f2bf(v1.y); q[6 * 2048] = (bf16_t)f2bf(v1.z); q[7 * 2048] = (bf16_t)f2bf(v1.w); }
            }
#pragma unroll
            for (int bj = 0; bj < 2; ++bj) { if (bj == 1 && pn > 14) continue; bf16_t* base = NK + (size_t)((pn - 14) * 2 + bj) * ((size_t)T * 128) + cl;
#pragma unroll
                for (int ai = 0; ai < 2; ++ai)
#pragma unroll
                    for (int m = 0; m < 4; ++m) { const f32x4 v0 = acc[ai][bj][m][0], v1 = acc[ai][bj][m][1];
                        u32x4 w; w.x = pk2(v0.x, v0.y); w.y = pk2(v0.z, v0.w); w.z = pk2(v1.x, v1.y); w.w = pk2(v1.z, v1.w);
                        *(u32x4*)(base + (size_t)(row0 + ai * 128 + m * 16) * 128) = w; } }
        } else {
            if (wc == 0) {
#pragma unroll
                for (int ai = 0; ai < 2; ++ai)
#pragma unroll
                    for (int m = 0; m < 4; ++m) { float* rp = SM + (size_t)(row0 + ai * 128 + m * 16) * 32 + 8 * fq;
                        *(f32x4*)rp = acc[ai][0][m][0]; *(f32x4*)(rp + 4) = acc[ai][0][m][1]; }
            }
        }
    }
};
struct EpiGate {
    static constexpr bool PERM = true, AFTER_DRAIN = false;
    bf16_t* GAB; bf16_t* GC; int pn0;
    __device__ __forceinline__ void operator()(const f32x4 (&acc)[2][2][4][2], const pg8::Unit& u, int wr, int wc, int fr, int fq) const {
        const int pn = u.pn + pn0, row0 = u.pm * 256 + wr * 64 + fr, cl = wc * 32 + 8 * fq, gi = pn >> 2;
        bf16_t* base = (gi < 2 ? GAB + (size_t)gi * ((size_t)T * 1024) : GC) + (pn & 3) * 256 + cl;
#pragma unroll
        for (int ai = 0; ai < 2; ++ai)
#pragma unroll
            for (int m = 0; m < 4; ++m) { bf16_t* rowp = base + (size_t)(row0 + ai * 128 + m * 16) * 1024;
#pragma unroll
                for (int bj = 0; bj < 2; ++bj) { const f32x4 v0 = acc[ai][bj][m][0], v1 = acc[ai][bj][m][1];
                    u32x4 w; w.x = pk2(sigm(v0.x), sigm(v0.y)); w.y = pk2(sigm(v0.z), sigm(v0.w)); w.z = pk2(sigm(v1.x), sigm(v1.y)); w.w = pk2(sigm(v1.z), sigm(v1.w));
                    *(u32x4*)(rowp + bj * 128) = w; } }
    }
};
struct EpiUp {
    static constexpr bool PERM = true, AFTER_DRAIN = false;
    bf16_t* MRG; const bf16_t* G; int first;
    __device__ __forceinline__ void operator()(const f32x4 (&acc)[2][2][4][2], const pg8::Unit& u, int wr, int wc, int fr, int fq) const {
        const int row0 = u.pm * 256 + wr * 64 + fr, c0 = u.pn * 256 + wc * 32 + 8 * fq;
#pragma unroll
        for (int ai = 0; ai < 2; ++ai)
#pragma unroll
            for (int m = 0; m < 4; ++m) { const size_t ro = (size_t)(row0 + ai * 128 + m * 16) * 1024 + c0;
#pragma unroll
                for (int bj = 0; bj < 2; ++bj) { const f32x4 v0 = acc[ai][bj][m][0], v1 = acc[ai][bj][m][1];
                    const u32x4 g = *(const u32x4*)(G + ro + bj * 128);
                    float o[8] = {bf_lo(g.x) * v0.x, bf_hi(g.x) * v0.y, bf_lo(g.y) * v0.z, bf_hi(g.y) * v0.w, bf_lo(g.z) * v1.x, bf_hi(g.z) * v1.y, bf_lo(g.w) * v1.z, bf_hi(g.w) * v1.w};
                    if (!first) { const u32x4 q = *(const u32x4*)(MRG + ro + bj * 128);
                        o[0] += bf_lo(q.x); o[1] += bf_hi(q.x); o[2] += bf_lo(q.y); o[3] += bf_hi(q.y); o[4] += bf_lo(q.z); o[5] += bf_hi(q.z); o[6] += bf_lo(q.w); o[7] += bf_hi(q.w); }
                    u32x4 w; w.x = pk2(o[0], o[1]); w.y = pk2(o[2], o[3]); w.z = pk2(o[4], o[5]); w.w = pk2(o[6], o[7]);
                    *(u32x4*)(MRG + ro + bj * 128) = w; } if (EPI_SB) __builtin_amdgcn_sched_barrier(0); }
    }
};
struct EpiRes {
    static constexpr bool PERM = true, AFTER_DRAIN = false;
    const float* xin; float* out; const float* gt;
    __device__ __forceinline__ void operator()(const f32x4 (&acc)[2][2][4][2], const pg8::Unit& u, int wr, int wc, int fr, int fq) const {
        const int row0 = u.pm * 256 + wr * 64 + fr, c0 = u.pn * 256 + wc * 32 + 8 * fq, b = (u.pm * 256) >> 11;
        const float* gp = gt + (size_t)b * 6144 + c0;
#pragma unroll
        for (int bj = 0; bj < 2; ++bj) { const f32x4 g0 = *(const f32x4*)(gp + bj * 128), g1 = *(const f32x4*)(gp + bj * 128 + 4);
#pragma unroll
            for (int ai = 0; ai < 2; ++ai)
#pragma unroll
                for (int m = 0; m < 4; ++m) { const size_t ro = (size_t)(row0 + ai * 128 + m * 16) * 1024 + c0 + bj * 128;
                    const f32x4 x0 = *(const f32x4*)(xin + ro), x1 = *(const f32x4*)(xin + ro + 4);
                    *(f32x4*)(out + ro) = x0 + g0 * acc[ai][bj][m][0];
                    *(f32x4*)(out + ro + 4) = x1 + g1 * acc[ai][bj][m][1]; if (EPI_SB && m == 3) __builtin_amdgcn_sched_barrier(0); } }
    }
};
struct EpiMlp1 {
    static constexpr bool PERM = true, AFTER_DRAIN = false;
    bf16_t* F;
    __device__ __forceinline__ void operator()(const f32x4 (&acc)[2][2][4][2], const pg8::Unit& u, int wr, int wc, int fr, int fq) const {
        const int row0 = u.pm * 256 + wr * 64 + fr, c0 = u.pn * 256 + wc * 32 + 8 * fq;
#pragma unroll
        for (int ai = 0; ai < 2; ++ai)
#pragma unroll
            for (int m = 0; m < 4; ++m) { bf16_t* rowp = F + (size_t)(row0 + ai * 128 + m * 16) * 4096 + c0;
#pragma unroll
                for (int bj = 0; bj < 2; ++bj) { f32x4 v0 = acc[ai][bj][m][0], v1 = acc[ai][bj][m][1];
                    v0 = __builtin_elementwise_max(v0, (f32x4){0.f, 0.f, 0.f, 0.f}); v1 = __builtin_elementwise_max(v1, (f32x4){0.f, 0.f, 0.f, 0.f}); v0 = v0 * v0; v1 = v1 * v1;
                    u32x4 w; w.x = pk2(v0.x, v0.y); w.y = pk2(v0.z, v0.w); w.z = pk2(v1.x, v1.y); w.w = pk2(v1.z, v1.w);
                    *(u32x4*)(rowp + bj * 128) = w; } }
    }
};
__device__ __forceinline__ int win_src_col(int n) { return n < 3072 ? n : n < 4352 ? n + 8 : n < 4360 ? n - 4352 + 3072 : n < 4384 ? n : n < 4608 ? -1 : n - 4608 + 4384; }
__device__ __forceinline__ void transpose_item(const float* src, int K, int Nsrc, bf16_t* dst, int mode, int item, int ntn, float* tile, int tid) {
    const int kb = item / ntn, nb = item % ntn, k0 = kb * 64, n0 = nb * 64;
    __syncthreads();
    { const int nn = tid & 63, kk0 = tid >> 6; int sc = n0 + nn; if (mode == 1) sc = win_src_col(sc);
#pragma unroll
      for (int i = 0; i < 8; ++i) { const int kk = kk0 + 8 * i; tile[kk * 65 + nn] = sc >= 0 ? src[(size_t)(k0 + kk) * Nsrc + sc] : 0.f; } }
    __syncthreads();
    { const int nn = tid >> 3, kc = tid & 7; const float* s = tile + (kc * 8) * 65 + nn;
      u32x4 o; o.x = pk2(s[0], s[65]); o.y = pk2(s[2 * 65], s[3 * 65]); o.z = pk2(s[4 * 65], s[5 * 65]); o.w = pk2(s[6 * 65], s[7 * 65]);
      *(u32x4*)(dst + (size_t)(n0 + nn) * K + k0 + kc * 8) = o; }
}
__device__ __forceinline__ void prep_phase(const KP& p, unsigned char* lds, int wv, int bid, int gdim) { unsigned char* ws_ = PWS(); const int tidx_ = wv * 64 + lane_id_v();
    const int tid = tidx_; float* fl = (float*)lds;
    constexpr int N_MOD = 192, N_B1 = 4, NITEMS = N_MOD + N_B1;
    float* modp = (float*)(ws_ + WS_MOD);
    for (int it = bid; it < NITEMS; it += gdim) {
        if (it < N_MOD) {
            const int l = it / 96, rem = it % 96, bq = rem / 24, n = (rem % 24) * 256 + (tid & 255), kh = tid >> 8;
            __syncthreads();
#pragma unroll
            for (int i = 0; i < 16; ++i) { const int idx = tid + 512 * i, k = idx >> 3, bb = idx & 7; fl[idx] = silu_(PIN(1)[(bq * 8 + bb) * 1024 + k]); }
            __syncthreads();
            const float* w = PIN(4) + (size_t)l * 1024 * 6144 + (size_t)(kh * 512) * 6144 + n; const float* cf = fl + kh * 512 * 8;
            float a[8] = {0.f, 0.f, 0.f, 0.f, 0.f, 0.f, 0.f, 0.f};
#pragma unroll 4
            for (int k = 0; k < 512; ++k) { const float wv = w[(size_t)k * 6144]; const f32x4 c0 = *(const f32x4*)(cf + k * 8), c1 = *(const f32x4*)(cf + k * 8 + 4);
                a[0] += c0.x * wv; a[1] += c0.y * wv; a[2] += c0.z * wv; a[3] += c0.w * wv; a[4] += c1.x * wv; a[5] += c1.y * wv; a[6] += c1.z * wv; a[7] += c1.w * wv; }
            __syncthreads();
            if (kh == 1) {
#pragma unroll
                for (int bb = 0; bb < 8; ++bb) fl[bb * 256 + (tid & 255)] = a[bb]; }
            __syncthreads();
            if (kh == 0) { const float bias = PIN(5)[l * 6144 + n];
#pragma unroll
                for (int bb = 0; bb < 8; ++bb) modp[((size_t)l * 32 + bq * 8 + bb) * 6144 + n] = a[bb] + fl[bb * 256 + (tid & 255)] + bias; }
            continue;
        }
        int r = it - N_MOD;
        {
            const int l = r >> 1, kv = r & 1; const float* pe = PIN(15 + kv) + l * 2048; const float* w1 = PIN(kv ? 19 : 17) + (size_t)l * 2048 * 64;
            const int n = tid & 63, part = tid >> 6; float a = 0.f;
            for (int k = part * 256; k < part * 256 + 256; ++k) a += pe[k] * w1[(size_t)k * 64 + n];
            __syncthreads(); fl[part * 64 + n] = a; __syncthreads();
            if (tid < 64) { float s = 0.f; for (int q = 0; q < 8; ++q) s += fl[q * 64 + tid]; ((float*)(ws_ + WS_BIAS1))[(l * 2 + kv) * 64 + tid] = s; }
        }
    }
    __syncthreads();
    {
        constexpr int J_IN = 16 * 240, J_UP = 8 * 32, J_OUT = 16 * 32, J_M1 = 16 * 128, J_M2 = 64 * 32, J_P1 = 32 * 2, J_P2 = 2;
        constexpr int PER_L = J_IN + 3 * J_UP + J_OUT + J_M1 + J_M2 + 2 * J_P1 + 2 * J_P2;
        float* scr = (float*)lds + wv * (64 * 33); const int lane = tid & 63;
        for (int it = bid * 8 + wv; it < 2 * PER_L; it += gdim * 8) {
            const int l = it / PER_L; int r = it % PER_L;
            unsigned char* wb = ws_ + WS_W + (size_t)l * W_LAYER;
            const float* W; bf16_t* WT; int K, Nsrc, nblk, mode = 0;
            if (r < J_IN) { W = PIN(6) + (size_t)l * 1024 * 7456; K = 1024; Nsrc = 7456; WT = (bf16_t*)(wb + WO_IN); nblk = 240; mode = 1; }
            else if ((r -= J_IN) < J_UP) { W = PIN(21) + (size_t)l * 512 * 1024; K = 512; Nsrc = 1024; WT = (bf16_t*)(wb + WO_UPA); nblk = 32; }
            else if ((r -= J_UP) < J_UP) { W = PIN(22) + (size_t)l * 512 * 1024; K = 512; Nsrc = 1024; WT = (bf16_t*)(wb + WO_UPB); nblk = 32; }
            else if ((r -= J_UP) < J_UP) { W = PIN(23) + (size_t)l * 512 * 1024; K = 512; Nsrc = 1024; WT = (bf16_t*)(wb + WO_UPC); nblk = 32; }
            else if ((r -= J_UP) < J_OUT) { W = PIN(24) + (size_t)l * 1024 * 1024; K = 1024; Nsrc = 1024; WT = (bf16_t*)(wb + WO_OUT); nblk = 32; }
            else if ((r -= J_OUT) < J_M1) { W = PIN(25) + (size_t)l * 1024 * 4096; K = 1024; Nsrc = 4096; WT = (bf16_t*)(wb + WO_M1); nblk = 128; }
            else if ((r -= J_M1) < J_M2) { W = PIN(26) + (size_t)l * 4096 * 1024; K = 4096; Nsrc = 1024; WT = (bf16_t*)(wb + WO_M2); nblk = 32; }
            else if ((r -= J_M2) < J_P1) { W = PIN(17) + (size_t)l * 2048 * 64; K = 2048; Nsrc = 64; WT = (bf16_t*)(wb + WO_PK1); nblk = 2; }
            else if ((r -= J_P1) < J_P1) { W = PIN(19) + (size_t)l * 2048 * 64; K = 2048; Nsrc = 64; WT = (bf16_t*)(wb + WO_PV1); nblk = 2; }
            else if ((r -= J_P1) < J_P2) { W = PIN(18) + (size_t)l * 64 * 64; K = 64; Nsrc = 64; WT = (bf16_t*)(wb + WO_PK2); nblk = 2; }
            else { r -= J_P2; W = PIN(20) + (size_t)l * 64 * 64; K = 64; Nsrc = 64; WT = (bf16_t*)(wb + WO_PV2); nblk = 2; }
            const int kb = r / nblk, nb = r % nblk, k0 = 64 * kb, n0 = 32 * nb;
            int sc = n0 + (lane & 31); if (mode == 1) sc = win_src_col(sc);
            const float* wsrc = W + (size_t)(k0 + (lane >> 5)) * Nsrc + (sc >= 0 ? sc : 0);
            __builtin_amdgcn_wave_barrier();
#pragma unroll 8
            for (int i = 0; i < 32; ++i) { const float v = wsrc[(size_t)(2 * i) * Nsrc]; scr[(2 * i + (lane >> 5)) * 33 + (lane & 31)] = sc >= 0 ? v : 0.f; }
            __builtin_amdgcn_wave_barrier();
            const int c = lane & 7;
#pragma unroll
            for (int j = 0; j < 4; ++j) { const int n = (lane >> 3) + 8 * j; const float* s = scr + (8 * c) * 33 + n;
                const u32x4 o = {pk2(s[0], s[33]), pk2(s[2 * 33], s[3 * 33]), pk2(s[4 * 33], s[5 * 33]), pk2(s[6 * 33], s[7 * 33])};
                *(u32x4*)(WT + (size_t)(n0 + n) * K + k0 + 8 * c) = o; }
        }
    }
    __syncthreads();
}

__device__ __forceinline__ void rms_phase(const float* xin, const float* gvec, const float* sh, const float* sc, bf16_t* outb, float* outf, int wv, int bid, int gdim) {
    const int tidx_ = wv * 64 + lane_id_v();
    const int lane = tidx_ & 63, gw = bid * 8 + (tidx_ >> 6), ngw = gdim * 8;
    constexpr int NR = 2;
    f32x4 gvv[4];
#pragma unroll
    for (int j = 0; j < 4; ++j) gvv[j] = *(const f32x4*)(gvec + 4 * (lane + 64 * j));
    for (int row = gw; row < T; row += NR * ngw) {
        f32x4 v[NR][4]; float s[NR]; int rr[NR];
#pragma unroll
        for (int q = 0; q < NR; ++q) { rr[q] = row + q * ngw < T ? row + q * ngw : row; const f32x4* xr = (const f32x4*)(xin + (size_t)rr[q] * 1024) + lane;
#pragma unroll
            for (int j = 0; j < 4; ++j) v[q][j] = xr[64 * j]; }
#pragma unroll
        for (int q = 0; q < NR; ++q) { s[q] = 0.f;
#pragma unroll
            for (int j = 0; j < 4; ++j) s[q] += (v[q][j].x * v[q][j].x + v[q][j].y * v[q][j].y) + (v[q][j].z * v[q][j].z + v[q][j].w * v[q][j].w); }
#pragma unroll
        for (int o = 1; o < 64; o <<= 1)
#pragma unroll
            for (int q = 0; q < NR; ++q) s[q] += __shfl_xor(s[q], o);
#pragma unroll
        for (int q = 0; q < NR; ++q) { const float r = rsqrtf(s[q] * (1.f / 1024.f) + 1e-6f); const int b = rr[q] >> 11; const bool wr_ = (q == 0) || (rr[q] != row);
#pragma unroll
            for (int j = 0; j < 4; ++j) { const int col = 4 * (lane + 64 * j); f32x4 y = v[q][j] * r * gvv[j];
                if (sc) y = y * (*(const f32x4*)(sc + (size_t)b * 6144 + col) + 1.f) + *(const f32x4*)(sh + (size_t)b * 6144 + col);
                if (wr_) { if (outb) { const u32x2 o = {pk2(y.x, y.y), pk2(y.z, y.w)}; *(u32x2*)(outb + (size_t)rr[q] * 1024 + col) = o; }
                           else *(f32x4*)(outf + (size_t)rr[q] * 1024 + col) = y; } } }
    }
}

__device__ __forceinline__ void rms_rows(const float* xin, const float* gvec, const float* sh, const float* sc, bf16_t* outb, float* outf, int wv, int rbeg, int rend) {
    const int lane = lane_id_v();
    for (int row = rbeg + wv; row < rend; row += 8) {
        const f32x4* xr = (const f32x4*)(xin + (size_t)row * 1024) + lane; f32x4 v[4]; float s = 0.f;
#pragma unroll
        for (int j = 0; j < 4; ++j) { v[j] = xr[64 * j]; s += (v[j].x * v[j].x + v[j].y * v[j].y) + (v[j].z * v[j].z + v[j].w * v[j].w); }
        const float rstd = rsqrtf(wave_sum(s) * (1.f / 1024.f) + 1e-6f); const int b = row >> 11;
#pragma unroll
        for (int j = 0; j < 4; ++j) { const int col = 4 * (lane + 64 * j); f32x4 y = v[j] * rstd * *(const f32x4*)(gvec + col);
            if (sc) y = y * (*(const f32x4*)(sc + (size_t)b * 6144 + col) + 1.f) + *(const f32x4*)(sh + (size_t)b * 6144 + col);
            if (outb) { u32x2 o = {pk2(y.x, y.y), pk2(y.z, y.w)}; *(u32x2*)(outb + (size_t)row * 1024 + col) = o; }
            else *(f32x4*)(outf + (size_t)row * 1024 + col) = y; }
    }
}

__device__ __forceinline__ void compress_wave(const KP& p, int l, int witem, int wv) { unsigned char* ws_ = PWS(); const int tidx_ = wv * 64 + lane_id_v();
    const int lane = tidx_ & 63, fr = lane & 15, fq = lane >> 4;
    const int ct = witem & 7, kv = (witem >> 3) & 1, g = (witem >> 4) & 1, b = witem >> 5;
    const unsigned char* wb = ws_ + WS_W + (size_t)l * W_LAYER;
    const bf16_t* src = (const bf16_t*)(ws_ + WS_NK + (size_t)kv * NKSLOT);
    const bf16_t* w1T = (const bf16_t*)(wb + (kv ? WO_PV1 : WO_PK1));
    const bf16_t* w2T = (const bf16_t*)(wb + (kv ? WO_PV2 : WO_PK2));
    const float* bias1 = (const float*)(ws_ + WS_BIAS1) + (l * 2 + kv) * 64;
    const int c = ct * 16 + fr, cc = c < 127 ? c : 126;
    const bf16_t* brow = src + (size_t)(b * 2048 + 16 * cc) * 128 + g * 64 + fq * 8;
    f32x4 acc[4];
#pragma unroll
    for (int i = 0; i < 4; ++i) acc[i] = (f32x4){0.f, 0.f, 0.f, 0.f};
#pragma unroll 8
    for (int ks = 0; ks < 64; ++ks) {
        const bf16x8 bfr = ld8(brow + (ks >> 1) * 128 + (ks & 1) * 32);
#pragma unroll
        for (int nt = 0; nt < 4; ++nt) { const bf16x8 afr = ld8(w1T + (size_t)(nt * 16 + fr) * 2048 + ks * 32 + fq * 8); acc[nt] = MFMA16(afr, bfr, acc[nt]); }
    }
#pragma unroll
    for (int nt = 0; nt < 4; ++nt) { const f32x4 bb = *(const f32x4*)(bias1 + nt * 16 + 4 * fq); f32x4 v = acc[nt] + bb; acc[nt] = (f32x4){gelu_t(v.x), gelu_t(v.y), gelu_t(v.z), gelu_t(v.w)}; }
    bf16_t* dstk = (bf16_t*)(ws_ + WS_KCMP) + ((size_t)(b * 2 + g) * 128 + c) * 64;
    bf16_t* dstv = (bf16_t*)(ws_ + WS_VCMP) + (size_t)(b * 2 + g) * 64 * 128 + c;
#pragma unroll
    for (int mt = 0; mt < 4; ++mt) { f32x4 o = (f32x4){0.f, 0.f, 0.f, 0.f};
#pragma unroll
        for (int pp = 0; pp < 2; ++pp) { const bf16_t* ar = w2T + (mt * 16 + fr) * 64 + 32 * pp + 4 * fq; o = MFMA16(ld44(ar, ar + 16), pack8(acc[2 * pp], acc[2 * pp + 1]), o); }
        if (c >= 127) o = (f32x4){0.f, 0.f, 0.f, 0.f};
        if (kv == 0) { const u32x2 w = {pk2(o.x, o.y), pk2(o.z, o.w)}; *(u32x2*)(dstk + mt * 16 + 4 * fq) = w; }
        else { bf16_t* q = dstv + (size_t)(mt * 16 + 4 * fq) * 128; q[0] = (bf16_t)f2bf(o.x); q[128] = (bf16_t)f2bf(o.y); q[256] = (bf16_t)f2bf(o.z); q[384] = (bf16_t)f2bf(o.w); } }
}

__device__ __forceinline__ void gmlp_item(const KP& p, int l, int item, unsigned char* lds, int wv, int dup, int wlds) { unsigned char* ws_ = PWS(); const int tidx_ = wv * 64 + lane_id_v();
    const int tid = tidx_, lane = tid & 63, fr = lane & 15, fq = lane >> 4, g = item & 3, ck = (item >> 2) & 15, b = item >> 6, tok0 = b * 2048 + ck * 128;
    bf16_t* VT = (bf16_t*)lds;
    const bf16_t* V = (const bf16_t*)(ws_ + WS_Z + 3 * ZSLOT); bf16_t* U = (bf16_t*)(ws_ + WS_Z); bf16_t* Uo = dup ? (bf16_t*)(ws_ + WS_GAB) : U;
    __syncthreads();
    { const int t = tid >> 2, part = tid & 3; const bf16_t* vr = V + (size_t)(tok0 + t) * 512 + part * 128; float s1 = 0.f, s2 = 0.f;
#pragma unroll
      for (int i = 0; i < 16; ++i) { const u32x4 q = *(const u32x4*)(vr + 8 * i); const float e[8] = {bf_lo(q.x), bf_hi(q.x), bf_lo(q.y), bf_hi(q.y), bf_lo(q.z), bf_hi(q.z), bf_lo(q.w), bf_hi(q.w)};
#pragma unroll
          for (int k = 0; k < 8; ++k) { s1 += e[k]; s2 += e[k] * e[k]; } }
      s1 += __shfl_xor(s1, 1); s1 += __shfl_xor(s1, 2); s2 += __shfl_xor(s2, 1); s2 += __shfl_xor(s2, 2);
      const float mu = s1 * (1.f / 512.f), var = s2 * (1.f / 512.f) - mu * mu, rstd = rsqrtf(fmaxf(var, 0.f) + 1e-6f);
      const bf16_t* vg = V + (size_t)(tok0 + t) * 512 + g * 128 + part * 32; const float* lg = PIN(7) + l * 512 + g * 128 + part * 32; const float* lb = PIN(8) + l * 512 + g * 128 + part * 32;
#pragma unroll
      for (int i = 0; i < 4; ++i) { const u32x4 q = *(const u32x4*)(vg + 8 * i); const float e[8] = {bf_lo(q.x), bf_hi(q.x), bf_lo(q.y), bf_hi(q.y), bf_lo(q.z), bf_hi(q.z), bf_lo(q.w), bf_hi(q.w)};
#pragma unroll
          for (int k = 0; k < 8; ++k) VT[(part * 32 + 8 * i + k) * 136 + t] = (bf16_t)f2bf((e[k] - mu) * rstd * lg[8 * i + k] + lb[8 * i + k]); } }
    __syncthreads();
    const float* Wg = PIN(9) + (size_t)(l * 4 + g) * 128 * 128; const float* bsg = PIN(10) + (l * 4 + g) * 128;
    u32x2 upre[8]; float bpre[8];
#pragma unroll
    for (int tt = 0; tt < 8; ++tt) { upre[tt] = *(const u32x2*)(U + (size_t)(tok0 + 16 * tt + fr) * 512 + g * 128 + 16 * wv + 4 * fq); bpre[tt] = bsg[16 * tt + fr]; }
#pragma unroll
    for (int tt = 0; tt < 8; ++tt) {
        f32x4 acc = (f32x4){0.f, 0.f, 0.f, 0.f}; const int t = 16 * tt + fr, nk = (16 * tt + 47) >> 5;
#pragma unroll 1
        for (int ks = 0; ks < nk; ++ks) { const int s0 = 32 * ks + 8 * fq;
            const bf16x8 afr = ld8(VT + (16 * wv + fr) * 136 + s0);
            if (wlds) { acc = MFMA16(afr, ld8(VT + 128 * 136 + t * 136 + s0), acc); continue; }
            const float* wp = Wg + (size_t)t * 128 + s0; f32x4 w0 = *(const f32x4*)wp, w1 = *(const f32x4*)(wp + 4);
            w0.x = s0 + 0 <= t ? w0.x : 0.f; w0.y = s0 + 1 <= t ? w0.y : 0.f; w0.z = s0 + 2 <= t ? w0.z : 0.f; w0.w = s0 + 3 <= t ? w0.w : 0.f;
            w1.x = s0 + 4 <= t ? w1.x : 0.f; w1.y = s0 + 5 <= t ? w1.y : 0.f; w1.z = s0 + 6 <= t ? w1.z : 0.f; w1.w = s0 + 7 <= t ? w1.w : 0.f;
            acc = MFMA16(afr, pack8(w0, w1), acc); }
        const size_t ix = (size_t)(tok0 + t) * 512 + g * 128 + 16 * wv + 4 * fq; const u32x2 uq = upre[tt]; const float bias = bpre[tt];
        const u32x2 ow = {pk2(bf_lo(uq.x) * (acc[0] + bias), bf_hi(uq.x) * (acc[1] + bias)), pk2(bf_lo(uq.y) * (acc[2] + bias), bf_hi(uq.y) * (acc[3] + bias))};
        *(u32x2*)(Uo + ix) = ow; }
}

__device__ __forceinline__ void gmlp_load_w(int l, int g, unsigned char* lds, int wv) {
    const int tid = wv * 64 + lane_id_v(); bf16_t* Wl = (bf16_t*)lds + 128 * 136; const float* Wg = PIN(9) + (size_t)(l * 4 + g) * 128 * 128;
    __syncthreads();
    for (int i = tid; i < 128 * 32; i += 512) { const int t = i >> 5, s0 = (i & 31) * 4; const f32x4 w = *(const f32x4*)(Wg + t * 128 + s0);
        const u32x2 o = {pk2(s0 <= t ? w.x : 0.f, s0 + 1 <= t ? w.y : 0.f), pk2(s0 + 2 <= t ? w.z : 0.f, s0 + 3 <= t ? w.w : 0.f)}; *(u32x2*)(Wl + t * 136 + s0) = o; }
    __syncthreads();
}
__device__ __forceinline__ void mlstm_item(const KP& p, int l, int item, unsigned char* lds, int wv, int dup) { unsigned char* ws_ = PWS(); const int tidx_ = wv * 64 + lane_id_v();
    const int tid = tidx_, lane = tid & 63, w = wv, fr = lane & 15, fq = lane >> 4, b = item >> 2, h = item & 3;
    bf16_t* Qs = (bf16_t*)lds; bf16_t* Ks = Qs + 64 * 136; bf16_t* Kt = Ks + 64 * 136; bf16_t* Vt = Kt + 128 * 72; bf16_t* Cb = Vt + 128 * 72; float* st = (float*)(Cb + 144 * 136); float* gwv = st + 1024 + wv * 320;
    const bf16_t* MQ = (const bf16_t*)(ws_ + WS_Z + 5 * ZSLOT); const bf16_t* MK = (const bf16_t*)(ws_ + WS_Z + 6 * ZSLOT); const bf16_t* MV = (const bf16_t*)(ws_ + WS_Z + 4 * ZSLOT);
    bf16_t* MO = (bf16_t*)(ws_ + WS_Z + 1 * ZSLOT); bf16_t* MOo = MO; const float* SM = (const float*)(ws_ + WS_SM);
    const float* cw = PIN(11) + l * 4096; const float* cb = PIN(12) + l * 1024; const float* gb = PIN(13) + l * 8; const float* ng = PIN(14) + l * 512;
    float* Wc = st + 1024 + 8 * 320 + 16;
    __syncthreads();
    for (int i = tid; i < 144 * 136 / 2; i += 512) ((unsigned*)Cb)[i] = 0u;
    for (int i = tid; i < 2 * 5 * 128; i += 512) { const int qk = i / 640, j = (i % 640) >> 7, chl = i & 127; Wc[i] = j < 4 ? cw[j * 1024 + qk * 512 + h * 128 + chl] : cb[qk * 512 + h * 128 + chl]; }
    f32x4 Cacc[8]; f32x4 Nacc = (f32x4){0.f, 0.f, 0.f, 0.f};
#pragma unroll
    for (int i = 0; i < 8; ++i) Cacc[i] = (f32x4){0.f, 0.f, 0.f, 0.f};
    float m_prev = 0.f;
    const int oct = tid >> 5, tg = tid & 31, ch = h * 128 + oct * 8, t0 = 2 * tg;
    u32x4 xq[5], xk[5], vv[2]; float gi, gf; u32x2 op[4];
#define ML_LOAD(cn) do { const int tokn = b * 2048 + (cn) * 64; \
        _Pragma("unroll") for (int jj = 0; jj < 5; ++jj) { int r = (cn) * 64 + t0 - 3 + jj; r = r < 0 ? 0 : r; \
            xq[jj] = *(const u32x4*)(MQ + (size_t)(b * 2048 + r) * 512 + ch); xk[jj] = *(const u32x4*)(MK + (size_t)(b * 2048 + r) * 512 + ch); } \
        { const bf16_t* vr = MV + (size_t)(tokn + lane) * 512 + h * 128 + w * 16; vv[0] = *(const u32x4*)vr; vv[1] = *(const u32x4*)(vr + 8); } \
        gi = SM[(size_t)(tokn + lane) * 32 + h]; gf = SM[(size_t)(tokn + lane) * 32 + 4 + h]; \
        _Pragma("unroll") for (int tt = 0; tt < 4; ++tt) op[tt] = *(const u32x2*)(MO + (size_t)(tokn + 16 * tt + fr) * 512 + h * 128 + 16 * w + 4 * fq); } while (0)
    ML_LOAD(0);
    for (int c = 0; c < 32; ++c) {
        const int tok0 = b * 2048 + c * 64;
        asm volatile("s_waitcnt lgkmcnt(0)\n\ts_barrier" ::: "memory");
        u32x2 opc[4];
#pragma unroll
        for (int tt = 0; tt < 4; ++tt) opc[tt] = op[tt];
#pragma unroll
        for (int qk = 0; qk < 2; ++qk) {
            float x[5][8];
#pragma unroll
            for (int jj = 0; jj < 5; ++jj) { const u32x4 q = qk ? xk[jj] : xq[jj]; const bool ok = (c * 64 + t0 - 3 + jj) >= 0;
                x[jj][0] = ok ? bf_lo(q.x) : 0.f; x[jj][1] = ok ? bf_hi(q.x) : 0.f; x[jj][2] = ok ? bf_lo(q.y) : 0.f; x[jj][3] = ok ? bf_hi(q.y) : 0.f;
                x[jj][4] = ok ? bf_lo(q.z) : 0.f; x[jj][5] = ok ? bf_hi(q.z) : 0.f; x[jj][6] = ok ? bf_lo(q.w) : 0.f; x[jj][7] = ok ? bf_hi(q.w) : 0.f; }
            float y0[8], y1[8];
            { const f32x4 b0 = *(const f32x4*)(Wc + (qk * 5 + 4) * 128 + oct * 8), b1 = *(const f32x4*)(Wc + (qk * 5 + 4) * 128 + oct * 8 + 4);
              y0[0] = b0.x; y0[1] = b0.y; y0[2] = b0.z; y0[3] = b0.w; y0[4] = b1.x; y0[5] = b1.y; y0[6] = b1.z; y0[7] = b1.w; }
#pragma unroll
            for (int i = 0; i < 8; ++i) y1[i] = y0[i];
#pragma unroll
            for (int j = 0; j < 4; ++j) { const f32x4 w0 = *(const f32x4*)(Wc + (qk * 5 + j) * 128 + oct * 8), w1 = *(const f32x4*)(Wc + (qk * 5 + j) * 128 + oct * 8 + 4);
                const float wt[8] = {w0.x, w0.y, w0.z, w0.w, w1.x, w1.y, w1.z, w1.w};
#pragma unroll
                for (int i = 0; i < 8; ++i) { y0[i] += wt[i] * x[j][i]; y1[i] += wt[i] * x[j + 1][i]; } }
            const float scl = qk ? 0.08838834764831845f : 1.f;
#pragma unroll
            for (int i = 0; i < 8; ++i) { y0[i] = silu_(y0[i]) * scl; y1[i] = silu_(y1[i]) * scl; }
            bf16_t* dstm = qk ? Ks : Qs;
            const u32x4 o0 = {pk2(y0[0], y0[1]), pk2(y0[2], y0[3]), pk2(y0[4], y0[5]), pk2(y0[6], y0[7])}, o1 = {pk2(y1[0], y1[1]), pk2(y1[2], y1[3]), pk2(y1[4], y1[5]), pk2(y1[6], y1[7])};
            *(u32x4*)(dstm + t0 * 136 + oct * 8) = o0; *(u32x4*)(dstm + (t0 + 1) * 136 + oct * 8) = o1;
            if (qk) {
#pragma unroll
                for (int i = 0; i < 8; ++i) *(unsigned*)(Kt + (oct * 8 + i) * 72 + t0) = pk2(y0[i], y1[i]); }
        }
        {
#pragma unroll
            for (int hh = 0; hh < 2; ++hh) { const unsigned wq[4] = {vv[hh].x, vv[hh].y, vv[hh].z, vv[hh].w};
#pragma unroll
                for (int i = 0; i < 4; ++i) { Vt[(w * 16 + hh * 8 + 2 * i) * 72 + lane] = (bf16_t)(wq[i] & 0xffffu); Vt[(w * 16 + hh * 8 + 2 * i + 1) * 72 + lane] = (bf16_t)(wq[i] >> 16); } }
        }
        const float fi = gi + gb[h], ff = gf + gb[4 + h];
        { const int cn = c < 31 ? c + 1 : 31; ML_LOAD(cn); }
        const float lf = fminf(ff, 0.f) - __logf(1.f + __expf(-fabsf(ff)));
        float bc = lf;
#pragma unroll
        for (int o = 1; o < 64; o <<= 1) { const float v = __shfl_up(bc, o); if (lane >= o) bc += v; }
        const float cc = fi - bc; float pm = cc;
#pragma unroll
        for (int o = 1; o < 64; o <<= 1) { const float v = __shfl_up(pm, o); if (lane >= o) pm = fmaxf(pm, v); }
        float wprev, m_new;
        { const float M = fmaxf(m_prev, pm), m_t = bc + M, M63 = __shfl(M, 63);
          gwv[lane] = M; gwv[64 + lane] = cc; gwv[128 + lane] = __expf(m_prev - M); gwv[192 + lane] = __expf(-m_t); gwv[256 + lane] = __expf(cc - M63);
          wprev = __builtin_bit_cast(float, __builtin_amdgcn_readfirstlane(__builtin_bit_cast(int, __expf(m_prev - M63))));
          m_new = __builtin_bit_cast(float, __builtin_amdgcn_readfirstlane(__builtin_bit_cast(int, __shfl(m_t, 63)))); }
        asm volatile("s_waitcnt lgkmcnt(0)\n\ts_barrier" ::: "memory");
        float hv[4][4];
        {
            bf16x8 cf[4], nf[4];
#pragma unroll
            for (int kk = 0; kk < 4; ++kk) { cf[kk] = ld8(Cb + (16 * w + fr) * 136 + 32 * kk + 8 * fq); nf[kk] = ld8(Cb + (128 + fr) * 136 + 32 * kk + 8 * fq); }
#pragma unroll
            for (int tt = 0; tt < 4; ++tt) {
                bf16x8 qf[4];
#pragma unroll
                for (int kk = 0; kk < 4; ++kk) qf[kk] = ld8(Qs + (16 * tt + fr) * 136 + 32 * kk + 8 * fq);
                const float Mt = gwv[16 * tt + fr], wi = gwv[128 + 16 * tt + fr], en = gwv[192 + 16 * tt + fr];
                f32x4 a = (f32x4){0.f, 0.f, 0.f, 0.f}, dn = (f32x4){0.f, 0.f, 0.f, 0.f};
#pragma unroll
                for (int kk = 0; kk < 4; ++kk) { a = MFMA16(cf[kk], qf[kk], a); dn = MFMA16(nf[kk], qf[kk], dn); }
                const float nq = __shfl(dn[0], fr);
                f32x4 Nt = a * wi; float d1 = 0.f;
                f32x4 Pt[4];
#pragma unroll
                for (int s4 = 0; s4 < 4; ++s4) {
                    if (s4 > tt) { Pt[s4] = (f32x4){0.f, 0.f, 0.f, 0.f}; continue; }
                    f32x4 sv = (f32x4){0.f, 0.f, 0.f, 0.f};
#pragma unroll
                    for (int kk = 0; kk < 4; ++kk) sv = MFMA16(ld8(Ks + (16 * s4 + fr) * 136 + 32 * kk + 8 * fq), qf[kk], sv);
#pragma unroll
                    for (int j = 0; j < 4; ++j) { const int si = 16 * s4 + 4 * fq + j, ti = 16 * tt + fr; const float cs = gwv[64 + si];
                        sv[j] = (si <= ti) ? sv[j] * __expf(cs - Mt) : 0.f; d1 += sv[j]; }
                    Pt[s4] = sv; __builtin_amdgcn_sched_barrier(0);
                }
#pragma unroll
                for (int pp = 0; pp < 2; ++pp) { if (2 * pp > tt) continue;
                    const bf16_t* vr = Vt + (16 * w + fr) * 72 + 32 * pp + 4 * fq;
                    Nt = MFMA16(ld44(vr, vr + 16), pack8(Pt[2 * pp], Pt[2 * pp + 1]), Nt); }
                d1 = fq_sum(d1);
                const float inv = 1.f / fmaxf(fabsf(d1 + wi * nq), en); float s1 = 0.f, s2 = 0.f;
#pragma unroll
                for (int j = 0; j < 4; ++j) { hv[tt][j] = Nt[j] * inv; s1 += hv[tt][j]; s2 += hv[tt][j] * hv[tt][j]; }
                s1 = fq_sum(s1); s2 = fq_sum(s2);
                if (fq == 0) { st[(w * 64 + 16 * tt + fr) * 2] = s1; st[(w * 64 + 16 * tt + fr) * 2 + 1] = s2; }
                __builtin_amdgcn_sched_barrier(0);
            }
        }
        asm volatile("s_waitcnt lgkmcnt(0)\n\ts_barrier" ::: "memory");
#pragma unroll
        for (int tt = 0; tt < 4; ++tt) { const int t = 16 * tt + fr; float S1 = 0.f, S2 = 0.f;
#pragma unroll
            for (int q = 0; q < 8; ++q) { S1 += st[(q * 64 + t) * 2]; S2 += st[(q * 64 + t) * 2 + 1]; }
            const float mu = S1 * (1.f / 128.f), var = S2 * (1.f / 128.f) - mu * mu, rstd = rsqrtf(fmaxf(var, 0.f) + 1e-6f);
            const size_t oix = (size_t)(tok0 + t) * 512 + h * 128 + 16 * w + 4 * fq; const u32x2 oq = opc[tt]; const f32x4 g4 = *(const f32x4*)(ng + h * 128 + 16 * w + 4 * fq);
            const float o0 = sigm(bf_lo(oq.x)) * (hv[tt][0] - mu) * rstd * g4.x, o1 = sigm(bf_hi(oq.x)) * (hv[tt][1] - mu) * rstd * g4.y,
                        o2 = sigm(bf_lo(oq.y)) * (hv[tt][2] - mu) * rstd * g4.z, o3 = sigm(bf_hi(oq.y)) * (hv[tt][3] - mu) * rstd * g4.w;
            const u32x2 ow = {pk2(o0, o1), pk2(o2, o3)}; *(u32x2*)(MOo + oix) = ow; }
#pragma unroll
        for (int i = 0; i < 8; ++i) Cacc[i] = Cacc[i] * wprev;
        Nacc = Nacc * wprev;
#pragma unroll
        for (int pp = 0; pp < 2; ++pp) {
            const f32x4 wla = *(const f32x4*)(gwv + 256 + 32 * pp + 8 * fq), wlb = *(const f32x4*)(gwv + 256 + 32 * pp + 8 * fq + 4);
            const float wl[8] = {wla.x, wla.y, wla.z, wla.w, wlb.x, wlb.y, wlb.z, wlb.w};
            const u32x4 vq = *(const u32x4*)(Vt + (16 * w + fr) * 72 + 32 * pp + 8 * fq);
            const u32x4 av = {pk2(bf_lo(vq.x) * wl[0], bf_hi(vq.x) * wl[1]), pk2(bf_lo(vq.y) * wl[2], bf_hi(vq.y) * wl[3]), pk2(bf_lo(vq.z) * wl[4], bf_hi(vq.z) * wl[5]), pk2(bf_lo(vq.w) * wl[6], bf_hi(vq.w) * wl[7])};
            u32x4 nv = {pk2(wl[0], wl[1]), pk2(wl[2], wl[3]), pk2(wl[4], wl[5]), pk2(wl[6], wl[7])};
            if (fr != 0) nv = (u32x4){0u, 0u, 0u, 0u};
            const bf16x8 afr = __builtin_bit_cast(bf16x8, av), nfr = __builtin_bit_cast(bf16x8, nv);
#pragma unroll
            for (int dt = 0; dt < 8; ++dt) Cacc[dt] = MFMA16(afr, ld8(Kt + (16 * dt + fr) * 72 + 32 * pp + 8 * fq), Cacc[dt]);
            Nacc = MFMA16(nfr, ld8(Kt + (16 * w + fr) * 72 + 32 * pp + 8 * fq), Nacc);
        }
#pragma unroll
        for (int dt = 0; dt < 8; ++dt)
#pragma unroll
            for (int j = 0; j < 4; ++j) Cb[(16 * w + 4 * fq + j) * 136 + 16 * dt + fr] = (bf16_t)f2bf(Cacc[dt][j]);
        if (fq == 0) Cb[128 * 136 + 16 * w + fr] = (bf16_t)f2bf(Nacc[0]);
        m_prev = m_new;
    }
    __syncthreads();
}
#ifndef FUSE_RMS
#define FUSE_RMS 0
#endif
#ifndef GSPLIT
#define GSPLIT 4
#endif
#ifndef NSA_EARLY
#define NSA_EARLY 0
#endif
#ifndef FAST_BAR
#define FAST_BAR 0
#endif
#ifndef NSA_CMP_SB
#define NSA_CMP_SB 1
#endif
#ifndef NSA_PART
#define NSA_PART 7
#endif
__device__ __forceinline__ void nsa_loadk(const bf16_t* Kb, int key0, bf16x8 (&kf)[2][2], int fr, int fq) {
#pragma unroll
    for (int s2 = 0; s2 < 2; ++s2)
#pragma unroll
        for (int kk = 0; kk < 2; ++kk) kf[s2][kk] = ld8(Kb + (size_t)(key0 + 16 * s2 + fr) * 128 + 32 * kk + 8 * fq);
}
__device__ __forceinline__ void nsa_step(const bf16_t* Kb, const bf16_t* VTb, int key0, int pk, bf16x8 (&kf)[2][2], const bf16x8 (&qf)[4][2], const float (&slope)[4],
                                         int lo, int t, bool on, float (&m)[4], float (&ls)[4], f32x4 (&Ob)[4][4], int fr, int fq) {
    bf16x8 kn[2][2], vf[4];
    nsa_loadk(Kb, pk, kn, fr, fq);
#pragma unroll
    for (int dt = 0; dt < 4; ++dt) { const bf16_t* vp = VTb + (size_t)(16 * dt + fr) * 2048 + key0 + 4 * fq; vf[dt] = ld44(vp, vp + 16); }
    const int kb = key0 + 4 * fq;
    float pen[8];
#pragma unroll
    for (int j = 0; j < 4; ++j) { const int k0 = kb + j, k1 = kb + 16 + j;
        pen[j] = (on && k0 >= lo && k0 <= t) ? 0.f : -__builtin_inff(); pen[4 + j] = (on && k1 >= lo && k1 <= t) ? 0.f : -__builtin_inff(); }
    const float tk = (float)(t - kb);
#pragma unroll
    for (int h = 0; h < 4; ++h) {
        f32x4 S0 = (f32x4){0.f, 0.f, 0.f, 0.f}, S1 = (f32x4){0.f, 0.f, 0.f, 0.f};
        S0 = MFMA16(kf[0][0], qf[h][0], S0); S0 = MFMA16(kf[0][1], qf[h][1], S0);
        S1 = MFMA16(kf[1][0], qf[h][0], S1); S1 = MFMA16(kf[1][1], qf[h][1], S1);
        const float base = -slope[h] * tk; float sc[8], mx = -1e30f;
#pragma unroll
        for (int j = 0; j < 4; ++j) {
            sc[j] = __builtin_fmaf(S0[j], 0.18033688011112042f, __builtin_fmaf(slope[h], (float)j, base)) + pen[j];
            sc[4 + j] = __builtin_fmaf(S1[j], 0.18033688011112042f, __builtin_fmaf(slope[h], (float)(16 + j), base)) + pen[4 + j];
            mx = fmaxf(mx, fmaxf(sc[j], sc[4 + j])); }
        mx = fq_max(mx);
        const float mn = fmaxf(m[h], mx), al = __builtin_amdgcn_exp2f(m[h] - mn); m[h] = mn;
        float ps = 0.f;
#pragma unroll
        for (int j = 0; j < 8; ++j) { sc[j] = __builtin_amdgcn_exp2f(sc[j] - mn); ps += sc[j]; }
        ls[h] = ls[h] * al + ps;
        const u32x4 pw = {pk2(sc[0], sc[1]), pk2(sc[2], sc[3]), pk2(sc[4], sc[5]), pk2(sc[6], sc[7])};
        const bf16x8 pf = __builtin_bit_cast(bf16x8, pw);
#pragma unroll
        for (int dt = 0; dt < 4; ++dt) { Ob[h][dt] = Ob[h][dt] * al; Ob[h][dt] = MFMA16(vf[dt], pf, Ob[h][dt]); }
        if (h & 1) __builtin_amdgcn_sched_barrier(0);
    }
#pragma unroll
    for (int s2 = 0; s2 < 2; ++s2)
#pragma unroll
        for (int kk = 0; kk < 2; ++kk) kf[s2][kk] = kn[s2][kk];
}
__device__ __forceinline__ void nsa_tile(const KP& p, int l, int witem, unsigned char* lds, int wv, int dup) {
    unsigned char* ws_ = PWS(); const int lane = lane_id_v(), fr = lane & 15, fq = lane >> 4;
    const int qt = witem & 127, g = (witem >> 7) & 1, b = witem >> 8, t0 = qt * 16, tok0 = b * 2048 + t0, t = t0 + fr, jt = t0 >> 6;
    float* ol = (float*)(lds + wv * 16384) + lane;
    bf16_t* NQ = (bf16_t*)(ws_ + WS_Z + 2 * ZSLOT); const float* gp = (const float*)(ws_ + WS_SM) + (size_t)(tok0 + fr) * 32 + 8 + g * 12;
    const bf16_t* NKb = (const bf16_t*)(ws_ + WS_NK);
    float slope[4];
#pragma unroll
    for (int h = 0; h < 4; ++h) slope[h] = exp2f(-(float)(g * 4 + h + 1));
    float impv[8];
#pragma unroll
    for (int i = 0; i < 8; ++i) impv[i] = 0.f;
    if (NSA_PART & 1) {
        const bf16_t* Kc = (const bf16_t*)(ws_ + WS_KCMP) + (size_t)(b * 2 + g) * 128 * 64; const bf16_t* VcT = (const bf16_t*)(ws_ + WS_VCMP) + (size_t)(b * 2 + g) * 64 * 128;
        const int srcl = (lane + 48) & 63;
#pragma unroll 1
        for (int h = 0; h < 4; ++h) {
            const float slope_h = exp2f(-(float)(g * 4 + h + 1));
            const bf16x8 qh0 = ld8(NQ + (size_t)(tok0 + fr) * 512 + (g * 4 + h) * 64 + 8 * fq), qh1 = ld8(NQ + (size_t)(tok0 + fr) * 512 + (g * 4 + h) * 64 + 32 + 8 * fq);
            f32x4 S[8]; float mx = -1e30f;
#pragma unroll
            for (int st = 0; st < 8; ++st) { f32x4 a = (f32x4){0.f, 0.f, 0.f, 0.f};
                if (NSA_CMP_SB && (st & 1) == 0) __builtin_amdgcn_sched_barrier(0);
                a = MFMA16(ld8(Kc + (size_t)(16 * st + fr) * 64 + 8 * fq), qh0, a); a = MFMA16(ld8(Kc + (size_t)(16 * st + fr) * 64 + 32 + 8 * fq), qh1, a);
#pragma unroll
                for (int j = 0; j < 4; ++j) { const int c = 16 * st + 4 * fq + j; const bool ok = (c < 127) && (16 * c + 31 <= t);
                    a[j] = ok ? a[j] * 0.125f - slope_h * ((float)t - (16.f * (float)c + 15.5f)) : -1e30f; mx = fmaxf(mx, a[j]); }
                S[st] = a; }
            mx = fq_max(mx);
            float sum = 0.f;
#pragma unroll
            for (int st = 0; st < 8; ++st)
#pragma unroll
                for (int j = 0; j < 4; ++j) { S[st][j] = S[st][j] > -1e29f ? __expf(S[st][j] - mx) : 0.f; sum += S[st][j]; }
            sum = fq_sum(sum);
            const float inv = sum > 0.f ? 1.f / sum : 0.f;
#pragma unroll
            for (int st = 0; st < 8; ++st) { S[st] = S[st] * inv;
                const float a3 = __shfl(S[st][3], srcl); const float b3 = st > 0 ? __shfl(S[st - 1][3], srcl) : 0.f;
                impv[st] += (S[st][0] + S[st][1]) + (S[st][2] + S[st][3]) + (fq > 0 ? a3 : b3); }
            f32x4 Oc[4];
#pragma unroll
            for (int dt = 0; dt < 4; ++dt) Oc[dt] = (f32x4){0.f, 0.f, 0.f, 0.f};
#pragma unroll
            for (int pp = 0; pp < 4; ++pp) { if (NSA_CMP_SB) __builtin_amdgcn_sched_barrier(0); const bf16x8 pf = pack8(S[2 * pp], S[2 * pp + 1]);
#pragma unroll
                for (int dt = 0; dt < 4; ++dt) { const bf16_t* vp = VcT + (size_t)(16 * dt + fr) * 128 + 32 * pp + 4 * fq; Oc[dt] = MFMA16(ld44(vp, vp + 16), pf, Oc[dt]); } }
            const float g0 = sigm(gp[h * 3 + 0]);
#pragma unroll
            for (int dt = 0; dt < 4; ++dt)
#pragma unroll
                for (int j = 0; j < 4; ++j) ol[((h * 4 + dt) * 4 + j) * 64] = g0 * Oc[dt][j];
            __builtin_amdgcn_sched_barrier(0);
        }
    }
    unsigned selq = 1u, umask = 1u;
    if (NSA_PART & 2) {
        float val[8];
#pragma unroll
        for (int st = 0; st < 8; ++st) { const int J = 4 * st + fq; val[st] = J > jt ? -1e30f : ((J == 0 || J == jt || J == jt - 1) ? 1e4f : impv[st]); }
        int rank[8];
#pragma unroll
        for (int st = 0; st < 8; ++st) rank[st] = 0;
#pragma unroll
        for (int sq = 0; sq < 4; ++sq)
#pragma unroll
            for (int s2 = 0; s2 < 8; ++s2) { const float o = __shfl(val[s2], fr + 16 * sq); const int J2 = 4 * s2 + sq;
#pragma unroll
                for (int st = 0; st < 8; ++st) { const int J = 4 * st + fq; rank[st] += (o > val[st] || (o == val[st] && J2 < J)) ? 1 : 0; } }
        unsigned mk = 0u;
#pragma unroll
        for (int st = 0; st < 8; ++st) { const int J = 4 * st + fq; if (rank[st] < 8 && J <= jt) mk |= 1u << J; }
        mk = fq_or(mk);
        selq = mk; unsigned um = mk;
        um |= __shfl_xor(um, 1); um |= __shfl_xor(um, 2); um |= __shfl_xor(um, 4); um |= __shfl_xor(um, 8);
        umask = __builtin_amdgcn_readfirstlane(um);
    }
    __builtin_amdgcn_sched_barrier(0);
#pragma unroll
    for (int h = 0; h < 4; ++h) slope[h] *= 1.4426950408889634f;
    bf16x8 qf[4][2];
#pragma unroll
    for (int h = 0; h < 4; ++h)
#pragma unroll
        for (int kk = 0; kk < 2; ++kk) qf[h][kk] = ld8(NQ + (size_t)(tok0 + fr) * 512 + (g * 4 + h) * 64 + 32 * kk + 8 * fq);
#pragma unroll 1
    for (int br = 1; br < 3; ++br) { if (!(NSA_PART & 4)) break;
        const bf16_t* Kb = NKb + (size_t)(2 * br) * ((size_t)T * 128) + (size_t)b * 2048 * 128 + g * 64;
        const bf16_t* VTb = NKb + (size_t)(2 * br + 1) * ((size_t)T * 128) + (size_t)(b * 2 + g) * 64 * 2048;
        float m[4] = {-1e30f, -1e30f, -1e30f, -1e30f}, ls[4] = {0.f, 0.f, 0.f, 0.f}; f32x4 Ob[4][4];
#pragma unroll
        for (int h = 0; h < 4; ++h)
#pragma unroll
            for (int dt = 0; dt < 4; ++dt) Ob[h][dt] = (f32x4){0.f, 0.f, 0.f, 0.f};
        {
            unsigned mk = umask; int key0;
            if (br == 1) { key0 = 64 * __builtin_ctz(mk); mk &= mk - 1; }
            else { key0 = t0 - 511; key0 = key0 < 0 ? 0 : (key0 & ~31); }
            bf16x8 kf[2][2]; nsa_loadk(Kb, key0, kf, fr, fq);
#pragma unroll 1
            while (key0 >= 0) {
                int nk;
                if (br == 1) { if ((key0 & 32) == 0 && key0 + 32 <= t0 + 15) nk = key0 + 32; else if (mk) { nk = 64 * __builtin_ctz(mk); mk &= mk - 1; } else nk = -1; }
                else nk = (key0 + 32 <= t0 + 15) ? key0 + 32 : -1;
                const bool on = br == 1 ? ((selq >> (key0 >> 6)) & 1u) : true;
                nsa_step(Kb, VTb, key0, nk >= 0 ? nk : key0, kf, qf, slope, br == 1 ? 0 : t - 511, t, on, m, ls, Ob, fr, fq);
                key0 = nk;
            }
        }
#pragma unroll
        for (int h = 0; h < 4; ++h) { float lt = ls[h]; lt = fq_sum(lt); const float sc = sigm(gp[h * 3 + br]) / lt;
#pragma unroll
            for (int dt = 0; dt < 4; ++dt) {
                if (br == 1) {
#pragma unroll
                    for (int j = 0; j < 4; ++j) ol[((h * 4 + dt) * 4 + j) * 64] += sc * Ob[h][dt][j];
                } else {
                    float o[4];
#pragma unroll
                    for (int j = 0; j < 4; ++j) o[j] = ol[((h * 4 + dt) * 4 + j) * 64] + sc * Ob[h][dt][j];
                    const u32x2 w = {pk2(o[0], o[1]), pk2(o[2], o[3])}; *(u32x2*)((dup ? (bf16_t*)(ws_ + WS_GAB) : NQ) + (size_t)(tok0 + fr) * 512 + (g * 4 + h) * 64 + 16 * dt + 4 * fq) = w;
                } } }
    }
}

#define GEMM_RUN(GB, EPI, E, Aptr, Bptr, N_, K_) do { pg8::Gemm gg{(const bf16_t*)(Aptr), (const bf16_t*)(Bptr), T, (N_), (K_)}; pg8::StaticOrder SO; SO.init(T, (N_), gdim, bid); \
    if (EN & (GB)) pg8::gemm_phase<EPI, pg8::StaticOrder, true, true>((PG8_LAS unsigned char*)lds, gg, SO, E, wv); __syncthreads(); } while (0)

#define GEMM_RUN_SUB(GB, EPI, E, Aptr, Bptr, N_, K_, G_, C_) do { pg8::Gemm gg{(const bf16_t*)(Aptr), (const bf16_t*)(Bptr), T, (N_), (K_)}; pg8::StaticOrder SO; SO.init(T, (N_), (G_), (C_)); \
    if (EN & (GB)) pg8::gemm_phase<EPI, pg8::StaticOrder, true, true>((PG8_LAS unsigned char*)lds, gg, SO, E, wv); __syncthreads(); } while (0)
#define GEMM_RUN_PANEL(GB, EPI, E, Aptr, Bptr, N_, K_) do { pg8::Gemm gg{(const bf16_t*)(Aptr), (const bf16_t*)(Bptr), T, (N_), (K_)}; PanelOrder SO{bid, (N_) / 256}; \
    if (EN & (GB)) pg8::gemm_phase<EPI, PanelOrder, true, true>((PG8_LAS unsigned char*)lds, gg, SO, E, wv); __syncthreads(); if (threadIdx.x == 0) __threadfence(); __syncthreads(); } while (0)
template <int EN> __global__ void __launch_bounds__(512, 2) mega_fwd(KP p) {
    extern __shared__ __attribute__((aligned(16))) unsigned char lds[];
    const int wv0 = __builtin_amdgcn_readfirstlane(threadIdx.x >> 6);
    if (threadIdx.x == 0) { unsigned long long* tab = (unsigned long long*)(lds + TAB_OFF);
        tab[0] = (unsigned long long)p.in[0]; tab[1] = (unsigned long long)p.in[1]; tab[2] = (unsigned long long)p.in[2]; tab[3] = (unsigned long long)p.in[3]; tab[4] = (unsigned long long)p.in[4];
        tab[5] = (unsigned long long)p.in[5]; tab[6] = (unsigned long long)p.in[6]; tab[7] = (unsigned long long)p.in[7]; tab[8] = (unsigned long long)p.in[8]; tab[9] = (unsigned long long)p.in[9];
        tab[10] = (unsigned long long)p.in[10]; tab[11] = (unsigned long long)p.in[11]; tab[12] = (unsigned long long)p.in[12]; tab[13] = (unsigned long long)p.in[13]; tab[14] = (unsigned long long)p.in[14];
        tab[15] = (unsigned long long)p.in[15]; tab[16] = (unsigned long long)p.in[16]; tab[17] = (unsigned long long)p.in[17]; tab[18] = (unsigned long long)p.in[18]; tab[19] = (unsigned long long)p.in[19];
        tab[20] = (unsigned long long)p.in[20]; tab[21] = (unsigned long long)p.in[21]; tab[22] = (unsigned long long)p.in[22]; tab[23] = (unsigned long long)p.in[23]; tab[24] = (unsigned long long)p.in[24];
        tab[25] = (unsigned long long)p.in[25]; tab[26] = (unsigned long long)p.in[26]; tab[27] = (unsigned long long)p.in[27]; tab[28] = (unsigned long long)p.out; tab[29] = (unsigned long long)p.ws; }
    const int ph_lo = p.lo, ph_hi = p.hi; unsigned nbar = 0;
    __syncthreads();
    for (int ph = ph_lo; ph < ph_hi; ++ph) {
        const int bid = blockIdx.x, gdim = gridDim.x, wv = wv0;
        const bool fuse_rms = FUSE_RMS && gdim == 256;
        if (fuse_rms && (ph == NPHASE - 1 || ph == 7 || ph == 10 || ph == 16)) continue;
        if (ph == 0) { if (EN & 1) prep_phase(p, lds, wv, bid, gdim); }
        else if (ph == NPHASE - 1) rms_phase(POUT(), PIN(27), nullptr, nullptr, nullptr, POUT(), wv, bid, gdim);
        else {
            const int l = (ph - 1) / 9, sub = (ph - 1) % 9;
#ifdef PROBE_REP
            for (int rep = 0; rep < (((PROBE_REP) >> sub) & 1) + 1; ++rep) {
#else
            {
#endif
            unsigned char* wb = PWS() + WS_W + (size_t)l * W_LAYER;
            const float* mod = (const float*)(PWS() + WS_MOD) + (size_t)l * 32 * 6144;
            const float* xin = l == 0 ? PIN(0) : POUT();
            if (sub == 0) rms_phase(xin, PIN(2) + l * 1024, mod, mod + 1024, (bf16_t*)(PWS() + WS_H), nullptr, wv, bid, gdim);
            else if (sub == 1) { EpiIn E{(bf16_t*)(PWS() + WS_Z), (bf16_t*)(PWS() + WS_NK), (float*)(PWS() + WS_SM)}; GEMM_RUN(32, EpiIn, E, PWS() + WS_H, wb + WO_IN, 4608, 1024); }
            else if (sub == 2) {
                const int dup = 0;
                if (gdim == 256) {
                    if (bid < 128) { if (EN & 2) mlstm_item(p, l, bid, lds, wv, dup); }
                    else { const int jb = bid - 128;
                        if (EN & 8) compress_wave(p, l, jb * 8 + wv, wv);
                        if (EN & 4) { gmlp_load_w(l, jb & 3, lds, wv); for (int k = 0; k < 16; ++k) gmlp_item(p, l, jb + 128 * k, lds, wv, dup, 1); } }
                } else
                for (int it = bid; it < 128 + 2048 + 128; it += gdim) {
                    if (it < 128) { if (EN & 2) mlstm_item(p, l, it, lds, wv, dup); }
                    else if (it < 128 + 2048) { if (EN & 4) gmlp_item(p, l, it - 128, lds, wv, dup, 0); }
                    else { if (EN & 8) { compress_wave(p, l, (it - 128 - 2048) * 8 + wv, wv); } }
                }
                __syncthreads();
                if (gdim == 256 && bid >= 128) {
                    EpiGate E{(bf16_t*)(PWS() + WS_GAB), (bf16_t*)(PWS() + WS_GC), 0}; GEMM_RUN_SUB(64, EpiGate, E, PWS() + WS_H, wb + WO_IN + (size_t)4608 * 1024 * 2, GSPLIT * 256, 1024, 128, bid - 128);
                    if (NSA_EARLY > 0) grid_bar((unsigned*)PWS() + 64, 128u * (unsigned)(l + 1));
                    for (int bi = bid - 128; bi < NSA_EARLY; bi += 128) nsa_tile(p, l, ((bi & ~15) | (((bi & 15) + 4 * (bi >> 8)) & 15)) * 8 + wv, lds, wv, 0);
                    __syncthreads(); }
            }
            else if (sub == 3) {
                #ifdef PROBE_DUP
                for (int dup = ((PROBE_DUP) >> 3) & 1; dup >= 0; --dup)
#else
                const int dup = 0;
#endif
                const int vb = (gdim & 7) == 0 ? (bid & 7) * (gdim >> 3) + (bid >> 3) : bid;
                if (EN & 16) for (int bi = (gdim == 256 ? NSA_EARLY : 0) + vb; bi < 1024; bi += gdim) nsa_tile(p, l, ((bi & ~15) | (((bi & 15) + 4 * (bi >> 8)) & 15)) * 8 + wv, lds, wv, dup);
                __syncthreads();
                if (gdim == 256) { EpiGate E{(bf16_t*)(PWS() + WS_GAB), (bf16_t*)(PWS() + WS_GC), GSPLIT}; GEMM_RUN(64, EpiGate, E, PWS() + WS_H, wb + WO_IN + (size_t)(4608 + GSPLIT * 256) * 1024 * 2, 3072 - GSPLIT * 256, 1024); }
                else { EpiGate E{(bf16_t*)(PWS() + WS_GAB), (bf16_t*)(PWS() + WS_GC), 0}; GEMM_RUN(64, EpiGate, E, PWS() + WS_H, wb + WO_IN + (size_t)4608 * 1024 * 2, 3072, 1024); }
            }
            else if (sub == 4) {
                { EpiUp E{(bf16_t*)(PWS() + WS_MRG), (const bf16_t*)(PWS() + WS_GAB), 1}; GEMM_RUN(128, EpiUp, E, PWS() + WS_Z, wb + WO_UPA, 1024, 512); }
                { EpiUp E{(bf16_t*)(PWS() + WS_MRG), (const bf16_t*)(PWS() + WS_GAB) + (size_t)T * 1024, 0}; GEMM_RUN(128, EpiUp, E, PWS() + WS_Z + 1 * ZSLOT, wb + WO_UPB, 1024, 512); }
                { EpiUp E{(bf16_t*)(PWS() + WS_MRG), (const bf16_t*)(PWS() + WS_GC), 0}; GEMM_RUN(128, EpiUp, E, PWS() + WS_Z + 2 * ZSLOT, wb + WO_UPC, 1024, 512); }
            }
            else if (sub == 5) { EpiRes E{xin, POUT(), mod + 2048};
                if (fuse_rms) { GEMM_RUN_PANEL(256, EpiRes, E, PWS() + WS_MRG, wb + WO_OUT, 1024, 1024);
                    rms_rows(POUT(), PIN(3) + l * 1024, mod + 3072, mod + 4096, (bf16_t*)(PWS() + WS_H), nullptr, wv, 256 * bid, 256 * bid + 256); }
                else GEMM_RUN(256, EpiRes, E, PWS() + WS_MRG, wb + WO_OUT, 1024, 1024); }
            else if (sub == 6) rms_phase(POUT(), PIN(3) + l * 1024, mod + 3072, mod + 4096, (bf16_t*)(PWS() + WS_H), nullptr, wv, bid, gdim);
            else if (sub == 7) { EpiMlp1 E{(bf16_t*)(PWS() + WS_F)}; GEMM_RUN(512, EpiMlp1, E, PWS() + WS_H, wb + WO_M1, 4096, 1024); }
            else { EpiRes E{POUT(), POUT(), mod + 5120};
                if (fuse_rms) { GEMM_RUN_PANEL(256, EpiRes, E, PWS() + WS_F, wb + WO_M2, 1024, 4096);
                    if (l == 0) { const float* mod1 = (const float*)(PWS() + WS_MOD) + (size_t)32 * 6144; rms_rows(POUT(), PIN(2) + 1024, mod1, mod1 + 1024, (bf16_t*)(PWS() + WS_H), nullptr, wv, 256 * bid, 256 * bid + 256); }
                    else rms_rows(POUT(), PIN(27), nullptr, nullptr, nullptr, POUT(), wv, 256 * bid, 256 * bid + 256); }
                else GEMM_RUN(256, EpiRes, E, PWS() + WS_F, wb + WO_M2, 1024, 4096); }
            }
        }
        if (ph + 1 < ph_hi && !(fuse_rms && ph + 1 == NPHASE - 1)) {
            if (ph == ph_lo || !FAST_BAR) cg::this_grid().sync();
            else { ++nbar; grid_bar((unsigned*)PWS() + 128, (unsigned)gridDim.x * nbar); }
        }
    }
}

#ifndef MK_MULTI
#define MK_MULTI 0
#endif
#if MK_MULTI == 1
#define MAINK 992
#else
#define MAINK 1023
#endif
template <int EN> static void launch_plain(const KP& a, int grid, hipStream_t stream) {
    static bool attr = false;
    if (!attr) { (void)hipFuncSetAttribute((const void*)mega_fwd<EN>, hipFuncAttributeMaxDynamicSharedMemorySize, LDS_BYTES); attr = true; }
    hipLaunchKernelGGL(mega_fwd<EN>, dim3(grid), dim3(512), LDS_BYTES, stream, a);
}
extern "C" void kernel_launch(void* const* d_in, const int* in_sizes, int n_in, void* d_out, int out_size, void* d_ws, size_t ws_size, hipStream_t stream) {
    static int grid = 0;
    if (grid == 0) {
        if (n_in != 28 || out_size != T * DM || ws_size < WS_END) { fprintf(stderr, "kernel_launch: unexpected shapes n_in %d out %d ws %zu (need %zu)\n", n_in, out_size, ws_size, (size_t)WS_END); grid = -1; return; }
        int dev = 0, cus = 0, per_cu = 0;
        (void)hipGetDevice(&dev); (void)hipDeviceGetAttribute(&cus, hipDeviceAttributeMultiprocessorCount, dev);
        if (hipFuncSetAttribute((const void*)mega_fwd<MAINK>, hipFuncAttributeMaxDynamicSharedMemorySize, LDS_BYTES) != hipSuccess) { fprintf(stderr, "kernel_launch: hipFuncSetAttribute failed\n"); grid = -1; return; }
        if (hipOccupancyMaxActiveBlocksPerMultiprocessor(&per_cu, (const void*)mega_fwd<MAINK>, 512, LDS_BYTES) != hipSuccess || per_cu < 1) { fprintf(stderr, "kernel_launch: occupancy query says %d\n", per_cu); per_cu = 1; }
        (void)hipGetLastError();
        grid = cus * per_cu;
    }
    if (grid < 0) return;
    KP a{};
    for (int i = 0; i < 28; ++i) a.in[i] = (const float*)d_in[i];
    a.out = (float*)d_out; a.ws = (unsigned char*)d_ws;
#if MK_MULTI == 2
    for (int ph = 0; ph < NPHASE; ++ph) { a.lo = ph; a.hi = ph + 1; launch_plain<1023>(a, grid, stream); }
#elif MK_MULTI
    for (int ph = 0; ph < NPHASE; ++ph) { a.lo = ph; a.hi = ph + 1;
        const int sub = (ph == 0 || ph == NPHASE - 1) ? -1 : (ph - 1) % 9;
        if (ph == 0) launch_plain<1>(a, grid, stream);
        else if (sub == -1 || sub == 0 || sub == 6) launch_plain<0>(a, grid, stream);
        else if (sub == 2) { launch_plain<2>(a, grid, stream); launch_plain<4>(a, grid, stream); launch_plain<8>(a, grid, stream); }
        else if (sub == 3) { launch_plain<16>(a, grid, stream); launch_plain<992>(a, grid, stream); }
        else launch_plain<992>(a, grid, stream);
    }
#else
    a.lo = 0; a.hi = NPHASE;
    (void)hipMemsetAsync(d_ws, 0, 4096, stream);
    void* args[] = {&a};
    hipError_t e = hipLaunchCooperativeKernel((const void*)mega_fwd<1023>, dim3(grid), dim3(512), args, LDS_BYTES, stream);
    if (e != hipSuccess) fprintf(stderr, "cooperative launch failed: %s (grid %d)\n", hipGetErrorString(e), grid);
#endif
}
```

```cpp
#define GSPLIT 4
#define EPI_SB 0
#include <hip/hip_runtime.h>
#include <hip/hip_cooperative_groups.h>
#include <cstdio>
#include <cstdint>
namespace cg = cooperative_groups;
namespace pg8 {
#define PG8_LAS __attribute__((address_space(3)))
typedef unsigned short bf16_t;
typedef short bf16x8 __attribute__((ext_vector_type(8)));
typedef float f32x4 __attribute__((ext_vector_type(4)));
typedef unsigned u32x4 __attribute__((ext_vector_type(4)));
constexpr int BM = 256, BK = 64, HALF = 128, HTB = HALF * BK * 2  , STAGE_BYTES = 8 * HTB, NXCD = 8, WGM = 8;

__host__ __device__ __forceinline__ int lds_byte(int r, int c) { const int st = (r >> 4) * 2 + (c >> 5), rr = r & 15, cc = c & 31, ob = rr * 64 + cc * 2; return st * 1024 + (ob ^ (((ob >> 9) & 1) << 5)); }
__host__ __device__ __forceinline__ void stage_rc(int b, int& R, int& C) { const int st = b / 1024, sb = b % 1024, swz = sb ^ (((sb >> 9) & 1) << 5); R = (st >> 1) * 16 + swz / 64; C = (st & 1) * 32 + (swz % 64) / 2; }
__host__ __device__ __forceinline__ int perm32(int rho) { const int n = rho >> 4, i = rho & 15; return 8 * (i >> 2) + 4 * n + (i & 3); }

struct Unit { int pm, pn; };
struct Gemm { const bf16_t* A; const bf16_t* Bt; int M, N, K; };

struct StaticOrder {
    int nM, nN, nwg, G, c;
    __host__ __device__ void init(int M, int N, int G_, int c_) { nM = M / BM; nN = N / BM; nwg = nM * nN; G = G_; c = c_; }
    __host__ __device__ bool next(int i, Unit& u) const {
        const long L = (long)i * G + c; if (L >= nwg) return false;
        int wgid = (int)L; { const int q = nwg / NXCD, r = nwg % NXCD, xcd = wgid % NXCD, off = wgid / NXCD; wgid = (xcd < r ? xcd * (q + 1) : r * (q + 1) + (xcd - r) * q) + off; }
        const int nig = WGM * nN, gid = wgid / nig, fm = gid * WGM, gsz = (nM - fm) < WGM ? (nM - fm) : WGM;
        u.pm = fm + ((wgid % nig) % gsz); u.pn = (wgid % nig) / gsz; return true;
    }
    __device__ __forceinline__ void a_ready(const Unit&) const {}
    __device__ __forceinline__ void done(const Unit&) const {}
};

__device__ __forceinline__ unsigned cvt_pk_bf16(float lo, float hi) { unsigned r; asm volatile("v_cvt_pk_bf16_f32 %0, %1, %2" : "=v"(r) : "v"(lo), "v"(hi)); return r; }
template <class Epi, class Sched, bool ALIGN_EPI = false, bool SP2 = false>
__device__ __forceinline__ void gemm_phase(PG8_LAS unsigned char* lds, const Gemm g, const Sched& S, const Epi& E, int wv_) {
    int lane; asm volatile("v_mbcnt_lo_u32_b32 %0, -1, 0\n\tv_mbcnt_hi_u32_b32 %0, -1, %0" : "=v"(lane)); const int wid = wv_, tid = wv_ * 64 + lane, wr = wid >> 2, wc = wid & 3, fr = lane & 15, fq = lane >> 4;
    const int K = g.K, nt = K / BK;
    unsigned voffA[2], voffB[2];
#pragma unroll
    for (int i = 0; i < 2; ++i) { int R, C; stage_rc(tid * 16 + i * 8192, R, C); const int Rb = Epi::PERM ? ((R & ~31) + perm32(R & 31)) : R;
        voffA[i] = (unsigned)(R * K + C) * 2u; voffB[i] = (unsigned)(Rb * K + C) * 2u; }
    const size_t kstep = (size_t)(BK * 2);
    const size_t hstep = (size_t)HALF * K * 2;
    const size_t tstep = 2 * hstep;
    const unsigned ldsw = (unsigned)wid * 1024u;
    const int aoff = lds_byte(wr * 64 + fr, fq * 8), boff = lds_byte(wc * 32 + fr, fq * 8);
#define PG8_SA(b, h) (((b) * 2 + (h)) * HTB)
#define PG8_SB(b, h) ((4 + (b) * 2 + (h)) * HTB)
#define PG8_STAGE(bufoff, gbase, voff) do { _Pragma("unroll") for (int _i = 0; _i < 2; ++_i) \
        __builtin_amdgcn_global_load_lds((const unsigned*)((const char*)(gbase) + (voff)[_i]), (PG8_LAS unsigned*)(lds + (bufoff) + ldsw + _i * 8192), 16, 0, 0); } while (0)
#define PG8_LDA(dst, b, h) do { _Pragma("unroll") for (int m = 0; m < 4; ++m) _Pragma("unroll") for (int k = 0; k < 2; ++k) dst[m][k] = *(const PG8_LAS bf16x8*)(lds + PG8_SA(b, h) + aoff + m * 2048 + k * 1024); } while (0)
#define PG8_LDB(dst, b, h) do { _Pragma("unroll") for (int n = 0; n < 2; ++n) _Pragma("unroll") for (int k = 0; k < 2; ++k) dst[n][k] = *(const PG8_LAS bf16x8*)(lds + PG8_SB(b, h) + boff + n * 2048 + k * 1024); } while (0)
#define PG8_MMA(ai, bj, At, Bt) do { __builtin_amdgcn_s_setprio(1); _Pragma("unroll") for (int m = 0; m < 4; ++m) _Pragma("unroll") for (int n = 0; n < 2; ++n) _Pragma("unroll") for (int k = 0; k < 2; ++k) \
        acc[ai][bj][m][n] = __builtin_amdgcn_mfma_f32_16x16x32_bf16(Bt[n][k], At[m][k], acc[ai][bj][m][n], 0, 0, 0); __builtin_amdgcn_s_setprio(0); } while (0)
#define PG8_WAIT_V(n) asm volatile("s_waitcnt vmcnt(" #n ")" ::: "memory")
#define PG8_WAIT_L(n) asm volatile("s_waitcnt lgkmcnt(" #n ")" ::: "memory")
#define PG8_BAR __builtin_amdgcn_s_barrier()
#define PG8_SCHED __builtin_amdgcn_sched_barrier(0)
    Unit cur, nxt; int ui = 0;
    if (!S.next(0, cur)) return;
    f32x4 acc[2][2][4][2];
#pragma unroll
    for (int a = 0; a < 2; ++a)
#pragma unroll
        for (int b = 0; b < 2; ++b)
#pragma unroll
            for (int m = 0; m < 4; ++m)
#pragma unroll
                for (int n = 0; n < 2; ++n) acc[a][b][m][n] = (f32x4){0.f, 0.f, 0.f, 0.f};
    bf16x8 At[4][2], B0[2][2], B1[2][2];
    const char* cA = (const char*)g.A + (size_t)cur.pm * tstep; const char* cB = (const char*)g.Bt + (size_t)cur.pn * tstep;
    S.a_ready(cur);
    if constexpr (SP2) {
        PG8_STAGE(PG8_SB(0, 0), cB, voffB); PG8_STAGE(PG8_SB(0, 1), cB + hstep, voffB); PG8_STAGE(PG8_SA(0, 0), cA, voffA); PG8_STAGE(PG8_SA(0, 1), cA + hstep, voffA);
        if (wr == 1) PG8_BAR;
        PG8_WAIT_V(2); PG8_BAR;
        PG8_STAGE(PG8_SB(1, 0), cB + kstep, voffB); PG8_STAGE(PG8_SA(1, 0), cA + kstep, voffA); PG8_STAGE(PG8_SB(1, 1), cB + hstep + kstep, voffB);
        PG8_WAIT_V(6); PG8_BAR;
    } else {
        PG8_STAGE(PG8_SB(0, 0), cB, voffB); PG8_STAGE(PG8_SA(0, 0), cA, voffA); PG8_STAGE(PG8_SB(0, 1), cB + hstep, voffB); PG8_STAGE(PG8_SA(0, 1), cA + hstep, voffA);
        if (wr == 1) PG8_BAR;
        PG8_WAIT_V(4); PG8_BAR;
        PG8_STAGE(PG8_SB(1, 0), cB + kstep, voffB); PG8_STAGE(PG8_SA(1, 0), cA + kstep, voffA); PG8_STAGE(PG8_SB(1, 1), cB + hstep + kstep, voffB);
        PG8_WAIT_V(6); PG8_BAR;
    }
    for (;;) {
        const bool has_next = S.next(ui + 1, nxt);
        const char* nA = has_next ? (const char*)g.A + (size_t)nxt.pm * tstep : cA; const char* nB = has_next ? (const char*)g.Bt + (size_t)nxt.pn * tstep : cB;
        for (int t = 0; t < nt; t += 2) {
            const bool last = (t == nt - 2);
            const char* a1 = cA + (size_t)(t + 1) * kstep;
            const char* a2 = last ? nA : cA + (size_t)(t + 2) * kstep; const char* b2 = last ? nB : cB + (size_t)(t + 2) * kstep;
            const char* a3 = a2 + kstep; const char* b3 = b2 + kstep;
            if (last && has_next) S.a_ready(nxt);
            if constexpr (SP2) {
            PG8_LDB(B0, 0, 0); PG8_LDB(B1, 0, 1); PG8_SCHED; PG8_LDA(At, 0, 0); PG8_STAGE(PG8_SA(1, 1), a1 + hstep, voffA);
            PG8_WAIT_V(8); PG8_WAIT_L(0); PG8_BAR; PG8_MMA(0, 0, At, B0); PG8_MMA(0, 1, At, B1); PG8_BAR; PG8_SCHED;
            PG8_LDA(At, 0, 1); PG8_STAGE(PG8_SB(0, 0), b2, voffB); PG8_STAGE(PG8_SB(0, 1), b2 + hstep, voffB); PG8_STAGE(PG8_SA(0, 0), a2, voffA);
            PG8_WAIT_V(8); PG8_WAIT_L(0); PG8_BAR; PG8_MMA(1, 0, At, B0); PG8_MMA(1, 1, At, B1); PG8_BAR; PG8_SCHED;
            PG8_LDB(B0, 1, 0); PG8_LDB(B1, 1, 1); PG8_SCHED; PG8_LDA(At, 1, 0); PG8_STAGE(PG8_SA(0, 1), a2 + hstep, voffA);
            PG8_WAIT_V(8); PG8_WAIT_L(0); PG8_BAR; PG8_MMA(0, 0, At, B0); PG8_MMA(0, 1, At, B1); PG8_BAR; PG8_SCHED;
            PG8_LDA(At, 1, 1); PG8_STAGE(PG8_SB(1, 0), b3, voffB); PG8_STAGE(PG8_SB(1, 1), b3 + hstep, voffB); PG8_STAGE(PG8_SA(1, 0), a3, voffA);
            PG8_WAIT_V(8); PG8_WAIT_L(0); PG8_BAR; PG8_MMA(1, 0, At, B0); PG8_MMA(1, 1, At, B1); PG8_BAR; PG8_SCHED;
            } else {
            PG8_LDB(B0, 0, 0); PG8_SCHED; PG8_LDA(At, 0, 0); PG8_STAGE(PG8_SA(1, 1), a1 + hstep, voffA);
            PG8_WAIT_L(8); PG8_BAR; PG8_WAIT_L(0); PG8_MMA(0, 0, At, B0); PG8_BAR; PG8_SCHED;
            PG8_LDB(B1, 0, 1); PG8_STAGE(PG8_SB(0, 0), b2, voffB);
            PG8_BAR; PG8_WAIT_L(0); PG8_MMA(0, 1, At, B1); PG8_BAR;
            PG8_LDA(At, 0, 1); PG8_STAGE(PG8_SA(0, 0), a2, voffA);
            PG8_BAR; PG8_WAIT_L(0); PG8_MMA(1, 0, At, B0); PG8_BAR; PG8_SCHED;
            PG8_STAGE(PG8_SB(0, 1), b2 + hstep, voffB);
            PG8_WAIT_V(6); PG8_BAR; PG8_MMA(1, 1, At, B1); PG8_BAR;
            PG8_LDB(B0, 1, 0); PG8_SCHED; PG8_LDA(At, 1, 0); PG8_STAGE(PG8_SA(0, 1), a2 + hstep, voffA);
            PG8_WAIT_L(8); PG8_BAR; PG8_WAIT_L(0); PG8_MMA(0, 0, At, B0); PG8_BAR; PG8_SCHED;
            PG8_LDB(B1, 1, 1); PG8_STAGE(PG8_SB(1, 0), b3, voffB);
            PG8_BAR; PG8_WAIT_L(0); PG8_MMA(0, 1, At, B1); PG8_BAR;
            PG8_LDA(At, 1, 1); PG8_STAGE(PG8_SA(1, 0), a3, voffA);
            PG8_BAR; PG8_WAIT_L(0); PG8_MMA(1, 0, At, B0); PG8_BAR; PG8_SCHED;
            PG8_STAGE(PG8_SB(1, 1), b3 + hstep, voffB);
            PG8_WAIT_V(6); PG8_BAR; PG8_MMA(1, 1, At, B1); PG8_BAR;
            }
        }
        if constexpr (ALIGN_EPI) { if (wr == 0) PG8_BAR; }
        if constexpr (!Epi::AFTER_DRAIN) { E(acc, cur, wr, wc, fr, fq); S.done(cur); }
        if (!has_next) break;
#pragma unroll
        for (int a = 0; a < 2; ++a)
#pragma unroll
            for (int b = 0; b < 2; ++b)
#pragma unroll
                for (int m = 0; m < 4; ++m)
#pragma unroll
                    for (int n = 0; n < 2; ++n) acc[a][b][m][n] = (f32x4){0.f, 0.f, 0.f, 0.f};
        cur = nxt; cA = nA; cB = nB; ++ui;
        if constexpr (ALIGN_EPI) { if (wr == 1) PG8_BAR; }
    }
    PG8_WAIT_V(0);
    if constexpr (!ALIGN_EPI) { if (wr == 0) PG8_BAR; }
    PG8_BAR;
    if constexpr (Epi::AFTER_DRAIN) { E.fused(acc, cur, wr, wc, fr, fq, lds, wid, lane); S.done(cur); }
#undef PG8_SA
#undef PG8_SB
#undef PG8_STAGE
#undef PG8_LDA
#undef PG8_LDB
#undef PG8_MMA
#undef PG8_WAIT_V
#undef PG8_WAIT_L
#undef PG8_BAR
#undef PG8_SCHED
}
}
using pg8::bf16_t; using pg8::bf16x8; using pg8::f32x4; using pg8::u32x4;
typedef unsigned u32x2 __attribute__((ext_vector_type(2)));
typedef float f32x2v __attribute__((ext_vector_type(2)));

constexpr int T = 65536, DM = 1024, SEQ = 2048, NB = 32;
constexpr size_t MiB = 1u << 20;
constexpr size_t WS_MOD = 1 * MiB;
constexpr size_t WS_BIAS1 = 3 * MiB;
constexpr size_t WS_KCMP = 4 * MiB;
constexpr size_t WS_VCMP = 6 * MiB;
constexpr size_t WS_W = 8 * MiB;
constexpr size_t W_LAYER = 37 * MiB;
constexpr size_t WO_IN = 0, WO_UPA = 15 * MiB, WO_UPB = 16 * MiB, WO_UPC = 17 * MiB, WO_OUT = 18 * MiB, WO_M1 = 20 * MiB, WO_M2 = 28 * MiB,
                 WO_PK1 = 36 * MiB, WO_PV1 = 36 * MiB + 256 * 1024, WO_PK2 = 36 * MiB + 512 * 1024, WO_PV2 = 36 * MiB + 520 * 1024;
constexpr size_t WS_H = 82 * MiB;
constexpr size_t WS_Z = 210 * MiB;
constexpr size_t ZSLOT = 64 * MiB;
constexpr size_t WS_NK = 658 * MiB;
constexpr size_t NKSLOT = 16 * MiB;
constexpr size_t WS_SM = 754 * MiB;
constexpr size_t WS_GAB = 762 * MiB;
constexpr size_t WS_GC = WS_Z + 5 * ZSLOT;
constexpr size_t WS_MRG = WS_Z + 3 * ZSLOT;
constexpr size_t WS_F = WS_Z;
constexpr size_t WS_END = 1018 * MiB;
constexpr int LDS_BYTES = 135168;
constexpr int NPHASE = 20;

struct KP { const float* in[28]; float* out; unsigned char* ws; int lo, hi; };

typedef __bf16 bf16x2_hw __attribute__((ext_vector_type(2)));
__device__ __forceinline__ unsigned pk2(float lo, float hi) { const f32x2v v = {lo, hi}; const bf16x2_hw b = __builtin_convertvector(v, bf16x2_hw); return __builtin_bit_cast(unsigned, b); }
__device__ __forceinline__ unsigned f2bf(float f) { return pk2(f, f) & 0xffffu; }
__device__ __forceinline__ float bf_lo(unsigned u) { return __builtin_bit_cast(float, u << 16); }
__device__ __forceinline__ float bf_hi(unsigned u) { return __builtin_bit_cast(float, u & 0xffff0000u); }
__device__ __forceinline__ float bf1(bf16_t h) { return __builtin_bit_cast(float, ((unsigned)h) << 16); }
__device__ __forceinline__ float sigm(float x) { return __builtin_amdgcn_rcpf(1.f + __builtin_amdgcn_exp2f(-1.4426950408889634f * x)); }
__device__ __forceinline__ float gelu_t(float x) { const float x2 = x * x, u = x * __builtin_fmaf(x2, -0.10294324f, -2.3022082f); return x * __builtin_amdgcn_rcpf(1.f + __builtin_amdgcn_exp2f(u)); }
__device__ __forceinline__ float silu_(float x) { return x * __builtin_amdgcn_rcpf(1.f + __builtin_amdgcn_exp2f(-1.4426950408889634f * x)); }
__device__ __forceinline__ float wave_sum(float v) {
#pragma unroll
    for (int o = 1; o < 64; o <<= 1) v += __shfl_xor(v, o);
    return v;
}
__device__ __forceinline__ float wave_max(float v) {
#pragma unroll
    for (int o = 1; o < 64; o <<= 1) v = fmaxf(v, __shfl_xor(v, o));
    return v;
}
__device__ __forceinline__ bf16x8 ld8(const bf16_t* p) { return *(const bf16x8*)p; }
__device__ __forceinline__ bf16x8 ld44(const bf16_t* p0, const bf16_t* p1) { const u32x2 a = *(const u32x2*)p0, b = *(const u32x2*)p1; const u32x4 r = {a.x, a.y, b.x, b.y}; return __builtin_bit_cast(bf16x8, r); }
__device__ __forceinline__ bf16x8 pack8(f32x4 a, f32x4 b) { const u32x4 r = {pk2(a.x, a.y), pk2(a.z, a.w), pk2(b.x, b.y), pk2(b.z, b.w)}; return __builtin_bit_cast(bf16x8, r); }
__device__ __forceinline__ int lane_id_v() { int l; asm volatile("v_mbcnt_lo_u32_b32 %0, -1, 0\n\tv_mbcnt_hi_u32_b32 %0, -1, %0" : "=v"(l)); return l; }
constexpr int TAB_OFF = 132096;
__device__ __forceinline__ const float* ldsptr(int k) { extern __shared__ __attribute__((aligned(16))) unsigned char g_lds[];
    int koff = k * 8; asm volatile("" : "+v"(koff));
    const unsigned long long v = *(const unsigned long long*)(g_lds + TAB_OFF + koff);
    const unsigned lo = __builtin_amdgcn_readfirstlane((unsigned)v), hi = __builtin_amdgcn_readfirstlane((unsigned)(v >> 32));
    return (const float*)(((unsigned long long)hi << 32) | lo); }
#define PIN(k) ldsptr(k)
#define POUT() ((float*)ldsptr(28))
#define PWS() ((unsigned char*)ldsptr(29))
__device__ __forceinline__ void grid_bar(unsigned* cnt, unsigned target) {
    __threadfence(); __syncthreads();
    if (threadIdx.x == 0) {
        __hip_atomic_fetch_add(cnt, 1u, __ATOMIC_RELEASE, __HIP_MEMORY_SCOPE_AGENT);
        while (__hip_atomic_load(cnt, __ATOMIC_ACQUIRE, __HIP_MEMORY_SCOPE_AGENT) < target) __builtin_amdgcn_s_sleep(1);
    }
    __syncthreads(); __threadfence();
}
__device__ __forceinline__ float fq_max(float v) { v = fmaxf(v, __shfl_xor(v, 16)); return fmaxf(v, __shfl_xor(v, 32)); }
__device__ __forceinline__ float fq_sum(float v) { v += __shfl_xor(v, 16); return v + __shfl_xor(v, 32); }
__device__ __forceinline__ unsigned fq_or(unsigned u) { u |= __shfl_xor(u, 16); return u | __shfl_xor(u, 32); }
#define MFMA16(a, b, c) __builtin_amdgcn_mfma_f32_16x16x32_bf16((a), (b), (c), 0, 0, 0)

#ifndef EPI_SB
#define EPI_SB 1
#endif
struct PanelOrder {
    int pm, n;
    __device__ __forceinline__ bool next(int i, pg8::Unit& u) const { if (i >= n) return false; u.pm = pm; u.pn = i; return true; }
    __device__ __forceinline__ void a_ready(const pg8::Unit&) const {}
    __device__ __forceinline__ void done(const pg8::Unit&) const {}
};
struct EpiIn {
    static constexpr bool PERM = true, AFTER_DRAIN = false;
    bf16_t* Z; bf16_t* NK; float* SM;
    __device__ __forceinline__ void operator()(const f32x4 (&acc)[2][2][4][2], const pg8::Unit& u, int wr, int wc, int fr, int fq) const {
        const int pn = u.pn, row0 = u.pm * 256 + wr * 64 + fr, cl = wc * 32 + 8 * fq;
        if (pn < 14) {
            const int slot = (0x2146530 >> (4 * (pn >> 1))) & 7;
            bf16_t* base = Z + (size_t)slot * ((size_t)T * 512) + (pn & 1) * 256 + cl;
            const bool act = pn < 4;
#pragma unroll
            for (int ai = 0; ai < 2; ++ai)
#pragma unroll
                for (int m = 0; m < 4; ++m) { bf16_t* rowp = base + (size_t)(row0 + ai * 128 + m * 16) * 512;
#pragma unroll
                    for (int bj = 0; bj < 2; ++bj) { f32x4 v0 = acc[ai][bj][m][0], v1 = acc[ai][bj][m][1];
                        if (act) { v0 = (f32x4){gelu_t(v0.x), gelu_t(v0.y), gelu_t(v0.z), gelu_t(v0.w)}; v1 = (f32x4){gelu_t(v1.x), gelu_t(v1.y), gelu_t(v1.z), gelu_t(v1.w)}; }
                        u32x4 w; w.x = pk2(v0.x, v0.y); w.y = pk2(v0.z, v0.w); w.z = pk2(v1.x, v1.y); w.w = pk2(v1.z, v1.w);
                        *(u32x4*)(rowp + bj * 128) = w; } }
        } else if (pn < 17) {
            if (pn > 14) {
                bf16_t* vt = NK + (size_t)((pn - 14) * 2 + 1) * ((size_t)T * 128) + (size_t)(cl >> 6) * 64 * 2048 + (size_t)(cl & 63) * 2048;
#pragma unroll
                for (int ai = 0; ai < 2; ++ai)
#pragma unroll
                    for (int m = 0; m < 4; ++m) { const int r = row0 + ai * 128 + m * 16; bf16_t* q = vt + (size_t)(r >> 11) * (2 * 64 * 2048) + (r & 2047);
                        const f32x4 v0 = acc[ai][1][m][0], v1 = acc[ai][1][m][1];
                        q[0 * 2048] = (bf16_t)f2bf(v0.x); q[1 * 2048] = (bf16_t)f2bf(v0.y); q[2 * 2048] = (bf16_t)f2bf(v0.z); q[3 * 2048] = (bf16_t)f2bf(v0.w);
                        q[4 * 2048] = (bf16_t)f2bf(v1.x); q[5 * 2048] = (bf16_t)f2bf(v1.y); q[6 * 2048] = (bf16_t)f2bf(v1.z); q[7 * 2048] = (bf16_t)f2bf(v1.w); }
            }
#pragma unroll
            for (int bj = 0; bj < 2; ++bj) { if (bj == 1 && pn > 14) continue; bf16_t* base = NK + (size_t)((pn - 14) * 2 + bj) * ((size_t)T * 128) + cl;
#pragma unroll
                for (int ai = 0; ai < 2; ++ai)
#pragma unroll
                    for (int m = 0; m < 4; ++m) { const f32x4 v0 = acc[ai][bj][m][0], v1 = acc[ai][bj][m][1];
                        u32x4 w; w.x = pk2(v0.x, v0.y); w.y = pk2(v0.z, v0.w); w.z = pk2(v1.x, v1.y); w.w = pk2(v1.z, v1.w);
                        *(u32x4*)(base + (size_t)(row0 + ai * 128 + m * 16) * 128) = w; } }
        } else {
            if (wc == 0) {
#pragma unroll
                for (int ai = 0; ai < 2; ++ai)
#pragma unroll
                    for (int m = 0; m < 4; ++m) { float* rp = SM + (size_t)(row0 + ai * 128 + m * 16) * 32 + 8 * fq;
                        *(f32x4*)rp = acc[ai][0][m][0]; *(f32x4*)(rp + 4) = acc[ai][0][m][1]; }
            }
        }
    }
};
struct EpiGate {
    static constexpr bool PERM = true, AFTER_DRAIN = false;
    bf16_t* GAB; bf16_t* GC; int pn0;
    __device__ __forceinline__ void operator()(const f32x4 (&acc)[2][2][4][2], const pg8::Unit& u, int wr, int wc, int fr, int fq) const {
        const int pn = u.pn + pn0, row0 = u.pm * 256 + wr * 64 + fr, cl = wc * 32 + 8 * fq, gi = pn >> 2;
        bf16_t* base = (gi < 2 ? GAB + (size_t)gi * ((size_t)T * 1024) : GC) + (pn & 3) * 256 + cl;
#pragma unroll
        for (int ai = 0; ai < 2; ++ai)
#pragma unroll
            for (int m = 0; m < 4; ++m) { bf16_t* rowp = base + (size_t)(row0 + ai * 128 + m * 16) * 1024;
#pragma unroll
                for (int bj = 0; bj < 2; ++bj) { const f32x4 v0 = acc[ai][bj][m][0], v1 = acc[ai][bj][m][1];
                    u32x4 w; w.x = pk2(sigm(v0.x), sigm(v0.y)); w.y = pk2(sigm(v0.z), sigm(v0.w)); w.z = pk2(sigm(v1.x), sigm(v1.y)); w.w = pk2(sigm(v1.z), sigm(v1.w));
                    *(u32x4*)(rowp + bj * 128) = w; } }
    }
};
struct EpiUp {
    static constexpr bool PERM = true, AFTER_DRAIN = false;
    bf16_t* MRG; const bf16_t* G; int first;
    __device__ __forceinline__ void operator()(const f32x4 (&acc)[2][2][4][2], const pg8::Unit& u, int wr, int wc, int fr, int fq) const {
        const int row0 = u.pm * 256 + wr * 64 + fr, c0 = u.pn * 256 + wc * 32 + 8 * fq;
#pragma unroll
        for (int ai = 0; ai < 2; ++ai)
#pragma unroll
            for (int m = 0; m < 4; ++m) { const size_t ro = (size_t)(row0 + ai * 128 + m * 16) * 1024 + c0;
#pragma unroll
                for (int bj = 0; bj < 2; ++bj) { const f32x4 v0 = acc[ai][bj][m][0], v1 = acc[ai][bj][m][1];
                    const u32x4 g = *(const u32x4*)(G + ro + bj * 128);
                    float o[8] = {bf_lo(g.x) * v0.x, bf_hi(g.x) * v0.y, bf_lo(g.y) * v0.z, bf_hi(g.y) * v0.w, bf_lo(g.z) * v1.x, bf_hi(g.z) * v1.y, bf_lo(g.w) * v1.z, bf_hi(g.w) * v1.w};
                    if (!first) { const u32x4 q = *(const u32x4*)(MRG + ro + bj * 128);
                        o[0] += bf_lo(q.x); o[1] += bf_hi(q.x); o[2] += bf_lo(q.y); o[3] += bf_hi(q.y); o[4] += bf_lo(q.z); o[5] += bf_hi(q.z); o[6] += bf_lo(q.w); o[7] += bf_hi(q.w); }
                    u32x4 w; w.x = pk2(o[0], o[1]); w.y = pk2(o[2], o[3]); w.z = pk2(o[4], o[5]); w.w = pk2(o[6], o[7]);
                    *(u32x4*)(MRG + ro + bj * 128) = w; } if (EPI_SB) __builtin_amdgcn_sched_barrier(0); }
    }
};
struct EpiRes {
    static constexpr bool PERM = true, AFTER_DRAIN = false;
    const float* xin; float* out; const float* gt;
    __device__ __forceinline__ void operator()(const f32x4 (&acc)[2][2][4][2], const pg8::Unit& u, int wr, int wc, int fr, int fq) const {
        const int row0 = u.pm * 256 + wr * 64 + fr, c0 = u.pn * 256 + wc * 32 + 8 * fq, b = (u.pm * 256) >> 11;
        const float* gp = gt + (size_t)b * 6144 + c0;
#pragma unroll
        for (int bj = 0; bj < 2; ++bj) { const f32x4 g0 = *(const f32x4*)(gp + bj * 128), g1 = *(const f32x4*)(gp + bj * 128 + 4);
#pragma unroll
            for (int ai = 0; ai < 2; ++ai)
#pragma unroll
                for (int m = 0; m < 4; ++m) { const size_t ro = (size_t)(row0 + ai * 128 + m * 16) * 1024 + c0 + bj * 128;
                    const f32x4 x0 = *(const f32x4*)(xin + ro), x1 = *(const f32x4*)(xin + ro + 4);
                    *(f32x4*)(out + ro) = x0 + g0 * acc[ai][bj][m][0];
                    *(f32x4*)(out + ro + 4) = x1 + g1 * acc[ai][bj][m][1]; if (EPI_SB && m == 3) __builtin_amdgcn_sched_barrier(0); } }
    }
};
struct EpiMlp1 {
    static constexpr bool PERM = true, AFTER_DRAIN = false;
    bf16_t* F;
    __device__ __forceinline__ void operator()(const f32x4 (&acc)[2][2][4][2], const pg8::Unit& u, int wr, int wc, int fr, int fq) const {
        const int row0 = u.pm * 256 + wr * 64 + fr, c0 = u.pn * 256 + wc * 32 + 8 * fq;
#pragma unroll
        for (int ai = 0; ai < 2; ++ai)
#pragma unroll
            for (int m = 0; m < 4; ++m) { bf16_t* rowp = F + (size_t)(row0 + ai * 128 + m * 16) * 4096 + c0;
#pragma unroll
                for (int bj = 0; bj < 2; ++bj) { f32x4 v0 = acc[ai][bj][m][0], v1 = acc[ai][bj][m][1];
                    v0 = __builtin_elementwise_max(v0, (f32x4){0.f, 0.f, 0.f, 0.f}); v1 = __builtin_elementwise_max(v1, (f32x4){0.f, 0.f, 0.f, 0.f}); v0 = v0 * v0; v1 = v1 * v1;
                    u32x4 w; w.x = pk2(v0.x, v0.y); w.y = pk2(v0.z, v0.w); w.z = pk2(v1.x, v1.y); w.w = pk2(v1.z, v1.w);
                    *(u32x4*)(rowp + bj * 128) = w; } }
    }
};
__device__ __forceinline__ int win_src_col(int n) { return n < 3072 ? n : n < 4352 ? n + 8 : n < 4360 ? n - 4352 + 3072 : n < 4384 ? n : n < 4608 ? -1 : n - 4608 + 4384; }
__device__ __forceinline__ void transpose_item(const float* src, int K, int Nsrc, bf16_t* dst, int mode, int item, int ntn, float* tile, int tid) {
    const int kb = item / ntn, nb = item % ntn, k0 = kb * 64, n0 = nb * 64;
    __syncthreads();
    { const int nn = tid & 63, kk0 = tid >> 6; int sc = n0 + nn; if (mode == 1) sc = win_src_col(sc);
#pragma unroll
      for (int i = 0; i < 8; ++i) { const int kk = kk0 + 8 * i; tile[kk * 65 + nn] = sc >= 0 ? src[(size_t)(k0 + kk) * Nsrc + sc] : 0.f; } }
    __syncthreads();
    { const int nn = tid >> 3, kc = tid & 7; const float* s = tile + (kc * 8) * 65 + nn;
      u32x4 o; o.x = pk2(s[0], s[65]); o.y = pk2(s[2 * 65], s[3 * 65]); o.z = pk2(s[4 * 65], s[5 * 65]); o.w = pk2(s[6 * 65], s[7 * 65]);
      *(u32x4*)(dst + (size_t)(n0 + nn) * K + k0 + kc * 8) = o; }
}
__device__ __forceinline__ void prep_phase(const KP& p, unsigned char* lds, int wv, int bid, int gdim) { unsigned char* ws_ = PWS(); const int tidx_ = wv * 64 + lane_id_v();
    const int tid = tidx_; float* fl = (float*)lds;
    constexpr int N_MOD = 96, N_B1 = 4, NITEMS = N_MOD + N_B1;
    float* modp = (float*)(ws_ + WS_MOD);
    for (int it = bid; it < NITEMS; it += gdim) {
        if (it < N_MOD) {
            const int l = it / 48, rem = it % 48, bq = rem / 12, n = (rem % 12) * 512 + tid;
            __syncthreads();
#pragma unroll
            for (int i = 0; i < 16; ++i) { const int idx = tid + 512 * i, k = idx >> 3, bb = idx & 7; fl[idx] = silu_(PIN(1)[(bq * 8 + bb) * 1024 + k]); }
            __syncthreads();
            const float* w = PIN(4) + (size_t)l * 1024 * 6144 + n;
            float a[8] = {0.f, 0.f, 0.f, 0.f, 0.f, 0.f, 0.f, 0.f};
#pragma unroll 4
            for (int k = 0; k < 1024; ++k) { const float wv = w[(size_t)k * 6144]; const f32x4 c0 = *(const f32x4*)(fl + k * 8), c1 = *(const f32x4*)(fl + k * 8 + 4);
                a[0] += c0.x * wv; a[1] += c0.y * wv; a[2] += c0.z * wv; a[3] += c0.w * wv; a[4] += c1.x * wv; a[5] += c1.y * wv; a[6] += c1.z * wv; a[7] += c1.w * wv; }
            const float bias = PIN(5)[l * 6144 + n];
#pragma unroll
            for (int bb = 0; bb < 8; ++bb) modp[((size_t)l * 32 + bq * 8 + bb) * 6144 + n] = a[bb] + bias;
            continue;
        }
        int r = it - N_MOD;
        {
            const int l = r >> 1, kv = r & 1; const float* pe = PIN(15 + kv) + l * 2048; const float* w1 = PIN(kv ? 19 : 17) + (size_t)l * 2048 * 64;
            const int n = tid & 63, part = tid >> 6; float a = 0.f;
            for (int k = part * 256; k < part * 256 + 256; ++k) a += pe[k] * w1[(size_t)k * 64 + n];
            __syncthreads(); fl[part * 64 + n] = a; __syncthreads();
            if (tid < 64) { float s = 0.f; for (int q = 0; q < 8; ++q) s += fl[q * 64 + tid]; ((float*)(ws_ + WS_BIAS1))[(l * 2 + kv) * 64 + tid] = s; }
        }
    }
    __syncthreads();
    {
        constexpr int J_IN = 16 * 240, J_UP = 8 * 32, J_OUT = 16 * 32, J_M1 = 16 * 128, J_M2 = 64 * 32, J_P1 = 32 * 2, J_P2 = 2;
        constexpr int PER_L = J_IN + 3 * J_UP + J_OUT + J_M1 + J_M2 + 2 * J_P1 + 2 * J_P2;
        float* scr = (float*)lds + wv * (64 * 33); const int lane = tid & 63;
        for (int it = bid * 8 + wv; it < 2 * PER_L; it += gdim * 8) {
            const int l = it / PER_L; int r = it % PER_L;
            unsigned char* wb = ws_ + WS_W + (size_t)l * W_LAYER;
            const float* W; bf16_t* WT; int K, Nsrc, nblk, mode = 0;
            if (r < J_IN) { W = PIN(6) + (size_t)l * 1024 * 7456; K = 1024; Nsrc = 7456; WT = (bf16_t*)(wb + WO_IN); nblk = 240; mode = 1; }
            else if ((r -= J_IN) < J_UP) { W = PIN(21) + (size_t)l * 512 * 1024; K = 512; Nsrc = 1024; WT = (bf16_t*)(wb + WO_UPA); nblk = 32; }
            else if ((r -= J_UP) < J_UP) { W = PIN(22) + (size_t)l * 512 * 1024; K = 512; Nsrc = 1024; WT = (bf16_t*)(wb + WO_UPB); nblk = 32; }
            else if ((r -= J_UP) < J_UP) { W = PIN(23) + (size_t)l * 512 * 1024; K = 512; Nsrc = 1024; WT = (bf16_t*)(wb + WO_UPC); nblk = 32; }
            else if ((r -= J_UP) < J_OUT) { W = PIN(24) + (size_t)l * 1024 * 1024; K = 1024; Nsrc = 1024; WT = (bf16_t*)(wb + WO_OUT); nblk = 32; }
            else if ((r -= J_OUT) < J_M1) { W = PIN(25) + (size_t)l * 1024 * 4096; K = 1024; Nsrc = 4096; WT = (bf16_t*)(wb + WO_M1); nblk = 128; }
            else if ((r -= J_M1) < J_M2) { W = PIN(26) + (size_t)l * 4096 * 1024; K = 4096; Nsrc = 1024; WT = (bf16_t*)(wb + WO_M2); nblk = 32; }
            else if ((r -= J_M2) < J_P1) { W = PIN(17) + (size_t)l * 2048 * 64; K = 2048; Nsrc = 64; WT = (bf16_t*)(wb + WO_PK1); nblk = 2; }
            else if ((r -= J_P1) < J_P1) { W = PIN(19) + (size_t)l * 2048 * 64; K = 2048; Nsrc = 64; WT = (bf16_t*)(wb + WO_PV1); nblk = 2; }
            else if ((r -= J_P1) < J_P2) { W = PIN(18) + (size_t)l * 64 * 64; K = 64; Nsrc = 64; WT = (bf16_t*)(wb + WO_PK2); nblk = 2; }
            else { r -= J_P2; W = PIN(20) + (size_t)l * 64 * 64; K = 64; Nsrc = 64; WT = (bf16_t*)(wb + WO_PV2); nblk = 2; }
            const int kb = r / nblk, nb = r % nblk, k0 = 64 * kb, n0 = 32 * nb;
            int sc = n0 + (lane & 31); if (mode == 1) sc = win_src_col(sc);
            const float* wsrc = W + (size_t)(k0 + (lane >> 5)) * Nsrc + (sc >= 0 ? sc : 0);
            __builtin_amdgcn_wave_barrier();
#pragma unroll 8
            for (int i = 0; i < 32; ++i) { const float v = wsrc[(size_t)(2 * i) * Nsrc]; scr[(2 * i + (lane >> 5)) * 33 + (lane & 31)] = sc >= 0 ? v : 0.f; }
            __builtin_amdgcn_wave_barrier();
            const int c = lane & 7;
#pragma unroll
            for (int j = 0; j < 4; ++j) { const int n = (lane >> 3) + 8 * j; const float* s = scr + (8 * c) * 33 + n;
                const u32x4 o = {pk2(s[0], s[33]), pk2(s[2 * 33], s[3 * 33]), pk2(s[4 * 33], s[5 * 33]), pk2(s[6 * 33], s[7 * 33])};
                *(u32x4*)(WT + (size_t)(n0 + n) * K + k0 + 8 * c) = o; }
        }
    }
    __syncthreads();
}

__device__ __forceinline__ void rms_phase(const float* xin, const float* gvec, const float* sh, const float* sc, bf16_t* outb, float* outf, int wv, int bid, int gdim) {
    const int tidx_ = wv * 64 + lane_id_v();
    const int lane = tidx_ & 63, gw = bid * 8 + (tidx_ >> 6), ngw = gdim * 8;
    constexpr int NR = 2;
    f32x4 gvv[4];
#pragma unroll
    for (int j = 0; j < 4; ++j) gvv[j] = *(const f32x4*)(gvec + 4 * (lane + 64 * j));
    for (int row = gw; row < T; row += NR * ngw) {
        f32x4 v[NR][4]; float s[NR]; int rr[NR];
#pragma unroll
        for (int q = 0; q < NR; ++q) { rr[q] = row + q * ngw < T ? row + q * ngw : row; const f32x4* xr = (const f32x4*)(xin + (size_t)rr[q] * 1024) + lane;
#pragma unroll
            for (int j = 0; j < 4; ++j) v[q][j] = xr[64 * j]; }
#pragma unroll
        for (int q = 0; q < NR; ++q) { s[q] = 0.f;
#pragma unroll
            for (int j = 0; j < 4; ++j) s[q] += (v[q][j].x * v[q][j].x + v[q][j].y * v[q][j].y) + (v[q][j].z * v[q][j].z + v[q][j].w * v[q][j].w); }
#pragma unroll
        for (int o = 1; o < 64; o <<= 1)
#pragma unroll
            for (int q = 0; q < NR; ++q) s[q] += __shfl_xor(s[q], o);
#pragma unroll
        for (int q = 0; q < NR; ++q) { const float r = rsqrtf(s[q] * (1.f / 1024.f) + 1e-6f); const int b = rr[q] >> 11; const bool wr_ = (q == 0) || (rr[q] != row);
#pragma unroll
            for (int j = 0; j < 4; ++j) { const int col = 4 * (lane + 64 * j); f32x4 y = v[q][j] * r * gvv[j];
                if (sc) y = y * (*(const f32x4*)(sc + (size_t)b * 6144 + col) + 1.f) + *(const f32x4*)(sh + (size_t)b * 6144 + col);
                if (wr_) { if (outb) { const u32x2 o = {pk2(y.x, y.y), pk2(y.z, y.w)}; *(u32x2*)(outb + (size_t)rr[q] * 1024 + col) = o; }
                           else *(f32x4*)(outf + (size_t)rr[q] * 1024 + col) = y; } } }
    }
}

__device__ __forceinline__ void rms_rows(const float* xin, const float* gvec, const float* sh, const float* sc, bf16_t* outb, float* outf, int wv, int rbeg, int rend) {
    const int lane = lane_id_v();
    for (int row = rbeg + wv; row < rend; row += 8) {
        const f32x4* xr = (const f32x4*)(xin + (size_t)row * 1024) + lane; f32x4 v[4]; float s = 0.f;
#pragma unroll
        for (int j = 0; j < 4; ++j) { v[j] = xr[64 * j]; s += (v[j].x * v[j].x + v[j].y * v[j].y) + (v[j].z * v[j].z + v[j].w * v[j].w); }
        const float rstd = rsqrtf(wave_sum(s) * (1.f / 1024.f) + 1e-6f); const int b = row >> 11;
#pragma unroll
        for (int j = 0; j < 4; ++j) { const int col = 4 * (lane + 64 * j); f32x4 y = v[j] * rstd * *(const f32x4*)(gvec + col);
            if (sc) y = y * (*(const f32x4*)(sc + (size_t)b * 6144 + col) + 1.f) + *(const f32x4*)(sh + (size_t)b * 6144 + col);
            if (outb) { u32x2 o = {pk2(y.x, y.y), pk2(y.z, y.w)}; *(u32x2*)(outb + (size_t)row * 1024 + col) = o; }
            else *(f32x4*)(outf + (size_t)row * 1024 + col) = y; }
    }
}

__device__ __forceinline__ void compress_wave(const KP& p, int l, int witem, int wv) { unsigned char* ws_ = PWS(); const int tidx_ = wv * 64 + lane_id_v();
    const int lane = tidx_ & 63, fr = lane & 15, fq = lane >> 4;
    const int ct = witem & 7, kv = (witem >> 3) & 1, g = (witem >> 4) & 1, b = witem >> 5;
    const unsigned char* wb = ws_ + WS_W + (size_t)l * W_LAYER;
    const bf16_t* src = (const bf16_t*)(ws_ + WS_NK + (size_t)kv * NKSLOT);
    const bf16_t* w1T = (const bf16_t*)(wb + (kv ? WO_PV1 : WO_PK1));
    const bf16_t* w2T = (const bf16_t*)(wb + (kv ? WO_PV2 : WO_PK2));
    const float* bias1 = (const float*)(ws_ + WS_BIAS1) + (l * 2 + kv) * 64;
    const int c = ct * 16 + fr, cc = c < 127 ? c : 126;
    const bf16_t* brow = src + (size_t)(b * 2048 + 16 * cc) * 128 + g * 64 + fq * 8;
    f32x4 acc[4];
#pragma unroll
    for (int i = 0; i < 4; ++i) acc[i] = (f32x4){0.f, 0.f, 0.f, 0.f};
#pragma unroll 8
    for (int ks = 0; ks < 64; ++ks) {
        const bf16x8 bfr = ld8(brow + (ks >> 1) * 128 + (ks & 1) * 32);
#pragma unroll
        for (int nt = 0; nt < 4; ++nt) { const bf16x8 afr = ld8(w1T + (size_t)(nt * 16 + fr) * 2048 + ks * 32 + fq * 8); acc[nt] = MFMA16(afr, bfr, acc[nt]); }
    }
#pragma unroll
    for (int nt = 0; nt < 4; ++nt) { const f32x4 bb = *(const f32x4*)(bias1 + nt * 16 + 4 * fq); f32x4 v = acc[nt] + bb; acc[nt] = (f32x4){gelu_t(v.x), gelu_t(v.y), gelu_t(v.z), gelu_t(v.w)}; }
    bf16_t* dstk = (bf16_t*)(ws_ + WS_KCMP) + ((size_t)(b * 2 + g) * 128 + c) * 64;
    bf16_t* dstv = (bf16_t*)(ws_ + WS_VCMP) + (size_t)(b * 2 + g) * 64 * 128 + c;
#pragma unroll
    for (int mt = 0; mt < 4; ++mt) { f32x4 o = (f32x4){0.f, 0.f, 0.f, 0.f};
#pragma unroll
        for (int pp = 0; pp < 2; ++pp) { const bf16_t* ar = w2T + (mt * 16 + fr) * 64 + 32 * pp + 4 * fq; o = MFMA16(ld44(ar, ar + 16), pack8(acc[2 * pp], acc[2 * pp + 1]), o); }
        if (c >= 127) o = (f32x4){0.f, 0.f, 0.f, 0.f};
        if (kv == 0) { const u32x2 w = {pk2(o.x, o.y), pk2(o.z, o.w)}; *(u32x2*)(dstk + mt * 16 + 4 * fq) = w; }
        else { bf16_t* q = dstv + (size_t)(mt * 16 + 4 * fq) * 128; q[0] = (bf16_t)f2bf(o.x); q[128] = (bf16_t)f2bf(o.y); q[256] = (bf16_t)f2bf(o.z); q[384] = (bf16_t)f2bf(o.w); } }
}

__device__ __forceinline__ void gmlp_item(const KP& p, int l, int item, unsigned char* lds, int wv, int dup, int wlds) { unsigned char* ws_ = PWS(); const int tidx_ = wv * 64 + lane_id_v();
    const int tid = tidx_, lane = tid & 63, fr = lane & 15, fq = lane >> 4, g = item & 3, ck = (item >> 2) & 15, b = item >> 6, tok0 = b * 2048 + ck * 128;
    bf16_t* VT = (bf16_t*)lds;
    const bf16_t* V = (const bf16_t*)(ws_ + WS_Z + 3 * ZSLOT); bf16_t* U = (bf16_t*)(ws_ + WS_Z); bf16_t* Uo = dup ? (bf16_t*)(ws_ + WS_GAB) : U;
    __syncthreads();
    { const int t = tid >> 2, part = tid & 3; const bf16_t* vr = V + (size_t)(tok0 + t) * 512 + part * 128; float s1 = 0.f, s2 = 0.f;
#pragma unroll
      for (int i = 0; i < 16; ++i) { const u32x4 q = *(const u32x4*)(vr + 8 * i); const float e[8] = {bf_lo(q.x), bf_hi(q.x), bf_lo(q.y), bf_hi(q.y), bf_lo(q.z), bf_hi(q.z), bf_lo(q.w), bf_hi(q.w)};
#pragma unroll
          for (int k = 0; k < 8; ++k) { s1 += e[k]; s2 += e[k] * e[k]; } }
      s1 += __shfl_xor(s1, 1); s1 += __shfl_xor(s1, 2); s2 += __shfl_xor(s2, 1); s2 += __shfl_xor(s2, 2);
      const float mu = s1 * (1.f / 512.f), var = s2 * (1.f / 512.f) - mu * mu, rstd = rsqrtf(fmaxf(var, 0.f) + 1e-6f);
      const bf16_t* vg = V + (size_t)(tok0 + t) * 512 + g * 128 + part * 32; const float* lg = PIN(7) + l * 512 + g * 128 + part * 32; const float* lb = PIN(8) + l * 512 + g * 128 + part * 32;
#pragma unroll
      for (int i = 0; i < 4; ++i) { const u32x4 q = *(const u32x4*)(vg + 8 * i); const float e[8] = {bf_lo(q.x), bf_hi(q.x), bf_lo(q.y), bf_hi(q.y), bf_lo(q.z), bf_hi(q.z), bf_lo(q.w), bf_hi(q.w)};
#pragma unroll
          for (int k = 0; k < 8; ++k) VT[(part * 32 + 8 * i + k) * 136 + t] = (bf16_t)f2bf((e[k] - mu) * rstd * lg[8 * i + k] + lb[8 * i + k]); } }
    __syncthreads();
    const float* Wg = PIN(9) + (size_t)(l * 4 + g) * 128 * 128; const float* bsg = PIN(10) + (l * 4 + g) * 128;
    u32x2 upre[8]; float bpre[8];
#pragma unroll
    for (int tt = 0; tt < 8; ++tt) { upre[tt] = *(const u32x2*)(U + (size_t)(tok0 + 16 * tt + fr) * 512 + g * 128 + 16 * wv + 4 * fq); bpre[tt] = bsg[16 * tt + fr]; }
#pragma unroll
    for (int tt = 0; tt < 8; ++tt) {
        f32x4 acc = (f32x4){0.f, 0.f, 0.f, 0.f}; const int t = 16 * tt + fr, nk = (16 * tt + 47) >> 5;
#pragma unroll 1
        for (int ks = 0; ks < nk; ++ks) { const int s0 = 32 * ks + 8 * fq;
            const bf16x8 afr = ld8(VT + (16 * wv + fr) * 136 + s0);
            if (wlds) { acc = MFMA16(afr, ld8(VT + 128 * 136 + t * 136 + s0), acc); continue; }
            const float* wp = Wg + (size_t)t * 128 + s0; f32x4 w0 = *(const f32x4*)wp, w1 = *(const f32x4*)(wp + 4);
            w0.x = s0 + 0 <= t ? w0.x : 0.f; w0.y = s0 + 1 <= t ? w0.y : 0.f; w0.z = s0 + 2 <= t ? w0.z : 0.f; w0.w = s0 + 3 <= t ? w0.w : 0.f;
            w1.x = s0 + 4 <= t ? w1.x : 0.f; w1.y = s0 + 5 <= t ? w1.y : 0.f; w1.z = s0 + 6 <= t ? w1.z : 0.f; w1.w = s0 + 7 <= t ? w1.w : 0.f;
            acc = MFMA16(afr, pack8(w0, w1), acc); }
        const size_t ix = (size_t)(tok0 + t) * 512 + g * 128 + 16 * wv + 4 * fq; const u32x2 uq = upre[tt]; const float bias = bpre[tt];
        const u32x2 ow = {pk2(bf_lo(uq.x) * (acc[0] + bias), bf_hi(uq.x) * (acc[1] + bias)), pk2(bf_lo(uq.y) * (acc[2] + bias), bf_hi(uq.y) * (acc[3] + bias))};
        *(u32x2*)(Uo + ix) = ow; }
}

__device__ __forceinline__ void gmlp_load_w(int l, int g, unsigned char* lds, int wv) {
    const int tid = wv * 64 + lane_id_v(); bf16_t* Wl = (bf16_t*)lds + 128 * 136; const float* Wg = PIN(9) + (size_t)(l * 4 + g) * 128 * 128;
    __syncthreads();
    for (int i = tid; i < 128 * 32; i += 512) { const int t = i >> 5, s0 = (i & 31) * 4; const f32x4 w = *(const f32x4*)(Wg + t * 128 + s0);
        const u32x2 o = {pk2(s0 <= t ? w.x : 0.f, s0 + 1 <= t ? w.y : 0.f), pk2(s0 + 2 <= t ? w.z : 0.f, s0 + 3 <= t ? w.w : 0.f)}; *(u32x2*)(Wl + t * 136 + s0) = o; }
    __syncthreads();
}
__device__ __forceinline__ void mlstm_item(const KP& p, int l, int item, unsigned char* lds, int wv, int dup) { unsigned char* ws_ = PWS(); const int tidx_ = wv * 64 + lane_id_v();
    const int tid = tidx_, lane = tid & 63, w = wv, fr = lane & 15, fq = lane >> 4, b = item >> 2, h = item & 3;
    bf16_t* Qs = (bf16_t*)lds; bf16_t* Ks = Qs + 64 * 136; bf16_t* Kt = Ks + 64 * 136; bf16_t* Vt = Kt + 128 * 72; bf16_t* Cb = Vt + 128 * 72; float* st = (float*)(Cb + 144 * 136); float* gwv = st + 1024 + wv * 320;
    const bf16_t* MQ = (const bf16_t*)(ws_ + WS_Z + 5 * ZSLOT); const bf16_t* MK = (const bf16_t*)(ws_ + WS_Z + 6 * ZSLOT); const bf16_t* MV = (const bf16_t*)(ws_ + WS_Z + 4 * ZSLOT);
    bf16_t* MO = (bf16_t*)(ws_ + WS_Z + 1 * ZSLOT); bf16_t* MOo = MO; const float* SM = (const float*)(ws_ + WS_SM);
    const float* cw = PIN(11) + l * 4096; const float* cb = PIN(12) + l * 1024; const float* gb = PIN(13) + l * 8; const float* ng = PIN(14) + l * 512;
    float* Wc = st + 1024 + 8 * 320 + 16;
    __syncthreads();
    for (int i = tid; i < 144 * 136 / 2; i += 512) ((unsigned*)Cb)[i] = 0u;
    for (int i = tid; i < 2 * 5 * 128; i += 512) { const int qk = i / 640, j = (i % 640) >> 7, chl = i & 127; Wc[i] = j < 4 ? cw[j * 1024 + qk * 512 + h * 128 + chl] : cb[qk * 512 + h * 128 + chl]; }
    f32x4 Cacc[8]; f32x4 Nacc = (f32x4){0.f, 0.f, 0.f, 0.f};
#pragma unroll
    for (int i = 0; i < 8; ++i) Cacc[i] = (f32x4){0.f, 0.f, 0.f, 0.f};
    float m_prev = 0.f;
    const int oct = tid >> 5, tg = tid & 31, ch = h * 128 + oct * 8, t0 = 2 * tg;
    u32x4 xq[5], xk[5], vv[2]; float gi, gf; u32x2 op[4];
#define ML_LOAD(cn) do { const int tokn = b * 2048 + (cn) * 64; \
        _Pragma("unroll") for (int jj = 0; jj < 5; ++jj) { int r = (cn) * 64 + t0 - 3 + jj; r = r < 0 ? 0 : r; \
            xq[jj] = *(const u32x4*)(MQ + (size_t)(b * 2048 + r) * 512 + ch); xk[jj] = *(const u32x4*)(MK + (size_t)(b * 2048 + r) * 512 + ch); } \
        { const bf16_t* vr = MV + (size_t)(tokn + lane) * 512 + h * 128 + w * 16; vv[0] = *(const u32x4*)vr; vv[1] = *(const u32x4*)(vr + 8); } \
        gi = SM[(size_t)(tokn + lane) * 32 + h]; gf = SM[(size_t)(tokn + lane) * 32 + 4 + h]; \
        _Pragma("unroll") for (int tt = 0; tt < 4; ++tt) op[tt] = *(const u32x2*)(MO + (size_t)(tokn + 16 * tt + fr) * 512 + h * 128 + 16 * w + 4 * fq); } while (0)
    ML_LOAD(0);
    for (int c = 0; c < 32; ++c) {
        const int tok0 = b * 2048 + c * 64;
        asm volatile("s_waitcnt lgkmcnt(0)\n\ts_barrier" ::: "memory");
        u32x2 opc[4];
#pragma unroll
        for (int tt = 0; tt < 4; ++tt) opc[tt] = op[tt];
#pragma unroll
        for (int qk = 0; qk < 2; ++qk) {
            float x[5][8];
#pragma unroll
            for (int jj = 0; jj < 5; ++jj) { const u32x4 q = qk ? xk[jj] : xq[jj]; const bool ok = (c * 64 + t0 - 3 + jj) >= 0;
                x[jj][0] = ok ? bf_lo(q.x) : 0.f; x[jj][1] = ok ? bf_hi(q.x) : 0.f; x[jj][2] = ok ? bf_lo(q.y) : 0.f; x[jj][3] = ok ? bf_hi(q.y) : 0.f;
                x[jj][4] = ok ? bf_lo(q.z) : 0.f; x[jj][5] = ok ? bf_hi(q.z) : 0.f; x[jj][6] = ok ? bf_lo(q.w) : 0.f; x[jj][7] = ok ? bf_hi(q.w) : 0.f; }
            float y0[8], y1[8];
            { const f32x4 b0 = *(const f32x4*)(Wc + (qk * 5 + 4) * 128 + oct * 8), b1 = *(const f32x4*)(Wc + (qk * 5 + 4) * 128 + oct * 8 + 4);
              y0[0] = b0.x; y0[1] = b0.y; y0[2] = b0.z; y0[3] = b0.w; y0[4] = b1.x; y0[5] = b1.y; y0[6] = b1.z; y0[7] = b1.w; }
#pragma unroll
            for (int i = 0; i < 8; ++i) y1[i] = y0[i];
#pragma unroll
            for (int j = 0; j < 4; ++j) { const f32x4 w0 = *(const f32x4*)(Wc + (qk * 5 + j) * 128 + oct * 8), w1 = *(const f32x4*)(Wc + (qk * 5 + j) * 128 + oct * 8 + 4);
                const float wt[8] = {w0.x, w0.y, w0.z, w0.w, w1.x, w1.y, w1.z, w1.w};
#pragma unroll
                for (int i = 0; i < 8; ++i) { y0[i] += wt[i] * x[j][i]; y1[i] += wt[i] * x[j + 1][i]; } }
            const float scl = qk ? 0.08838834764831845f : 1.f;
#pragma unroll
            for (int i = 0; i < 8; ++i) { y0[i] = silu_(y0[i]) * scl; y1[i] = silu_(y1[i]) * scl; }
            bf16_t* dstm = qk ? Ks : Qs;
            const u32x4 o0 = {pk2(y0[0], y0[1]), pk2(y0[2], y0[3]), pk2(y0[4], y0[5]), pk2(y0[6], y0[7])}, o1 = {pk2(y1[0], y1[1]), pk2(y1[2], y1[3]), pk2(y1[4], y1[5]), pk2(y1[6], y1[7])};
            *(u32x4*)(dstm + t0 * 136 + oct * 8) = o0; *(u32x4*)(dstm + (t0 + 1) * 136 + oct * 8) = o1;
            if (qk) {
#pragma unroll
                for (int i = 0; i < 8; ++i) *(unsigned*)(Kt + (oct * 8 + i) * 72 + t0) = pk2(y0[i], y1[i]); }
        }
        {
#pragma unroll
            for (int hh = 0; hh < 2; ++hh) { const unsigned wq[4] = {vv[hh].x, vv[hh].y, vv[hh].z, vv[hh].w};
#pragma unroll
                for (int i = 0; i < 4; ++i) { Vt[(w * 16 + hh * 8 + 2 * i) * 72 + lane] = (bf16_t)(wq[i] & 0xffffu); Vt[(w * 16 + hh * 8 + 2 * i + 1) * 72 + lane] = (bf16_t)(wq[i] >> 16); } }
        }
        const float fi = gi + gb[h], ff = gf + gb[4 + h];
        { const int cn = c < 31 ? c + 1 : 31; ML_LOAD(cn); }
        const float lf = fminf(ff, 0.f) - __logf(1.f + __expf(-fabsf(ff)));
        float bc = lf;
#pragma unroll
        for (int o = 1; o < 64; o <<= 1) { const float v = __shfl_up(bc, o); if (lane >= o) bc += v; }
        const float cc = fi - bc; float pm = cc;
#pragma unroll
        for (int o = 1; o < 64; o <<= 1) { const float v = __shfl_up(pm, o); if (lane >= o) pm = fmaxf(pm, v); }
        float wprev, m_new;
        { const float M = fmaxf(m_prev, pm), m_t = bc + M, M63 = __shfl(M, 63);
          gwv[lane] = M; gwv[64 + lane] = cc; gwv[128 + lane] = __expf(m_prev - M); gwv[192 + lane] = __expf(-m_t); gwv[256 + lane] = __expf(cc - M63);
          wprev = __builtin_bit_cast(float, __builtin_amdgcn_readfirstlane(__builtin_bit_cast(int, __expf(m_prev - M63))));
          m_new = __builtin_bit_cast(float, __builtin_amdgcn_readfirstlane(__builtin_bit_cast(int, __shfl(m_t, 63)))); }
        asm volatile("s_waitcnt lgkmcnt(0)\n\ts_barrier" ::: "memory");
        float hv[4][4];
        {
            bf16x8 cf[4], nf[4];
#pragma unroll
            for (int kk = 0; kk < 4; ++kk) { cf[kk] = ld8(Cb + (16 * w + fr) * 136 + 32 * kk + 8 * fq); nf[kk] = ld8(Cb + (128 + fr) * 136 + 32 * kk + 8 * fq); }
#pragma unroll
            for (int tt = 0; tt < 4; ++tt) {
                bf16x8 qf[4];
#pragma unroll
                for (int kk = 0; kk < 4; ++kk) qf[kk] = ld8(Qs + (16 * tt + fr) * 136 + 32 * kk + 8 * fq);
                const float Mt = gwv[16 * tt + fr], wi = gwv[128 + 16 * tt + fr], en = gwv[192 + 16 * tt + fr];
                f32x4 a = (f32x4){0.f, 0.f, 0.f, 0.f}, dn = (f32x4){0.f, 0.f, 0.f, 0.f};
#pragma unroll
                for (int kk = 0; kk < 4; ++kk) { a = MFMA16(cf[kk], qf[kk], a); dn = MFMA16(nf[kk], qf[kk], dn); }
                const float nq = __shfl(dn[0], fr);
                f32x4 Nt = a * wi; float d1 = 0.f;
                f32x4 Pt[4];
#pragma unroll
                for (int s4 = 0; s4 < 4; ++s4) {
                    if (s4 > tt) { Pt[s4] = (f32x4){0.f, 0.f, 0.f, 0.f}; continue; }
                    f32x4 sv = (f32x4){0.f, 0.f, 0.f, 0.f};
#pragma unroll
                    for (int kk = 0; kk < 4; ++kk) sv = MFMA16(ld8(Ks + (16 * s4 + fr) * 136 + 32 * kk + 8 * fq), qf[kk], sv);
#pragma unroll
                    for (int j = 0; j < 4; ++j) { const int si = 16 * s4 + 4 * fq + j, ti = 16 * tt + fr; const float cs = gwv[64 + si];
                        sv[j] = (si <= ti) ? sv[j] * __expf(cs - Mt) : 0.f; d1 += sv[j]; }
                    Pt[s4] = sv; __builtin_amdgcn_sched_barrier(0);
                }
#pragma unroll
                for (int pp = 0; pp < 2; ++pp) { if (2 * pp > tt) continue;
                    const bf16_t* vr = Vt + (16 * w + fr) * 72 + 32 * pp + 4 * fq;
                    Nt = MFMA16(ld44(vr, vr + 16), pack8(Pt[2 * pp], Pt[2 * pp + 1]), Nt); }
                d1 = fq_sum(d1);
                const float inv = 1.f / fmaxf(fabsf(d1 + wi * nq), en); float s1 = 0.f, s2 = 0.f;
#pragma unroll
                for (int j = 0; j < 4; ++j) { hv[tt][j] = Nt[j] * inv; s1 += hv[tt][j]; s2 += hv[tt][j] * hv[tt][j]; }
                s1 = fq_sum(s1); s2 = fq_sum(s2);
                if (fq == 0) { st[(w * 64 + 16 * tt + fr) * 2] = s1; st[(w * 64 + 16 * tt + fr) * 2 + 1] = s2; }
                __builtin_amdgcn_sched_barrier(0);
            }
        }
        asm volatile("s_waitcnt lgkmcnt(0)\n\ts_barrier" ::: "memory");
#pragma unroll
        for (int tt = 0; tt < 4; ++tt) { const int t = 16 * tt + fr; float S1 = 0.f, S2 = 0.f;
#pragma unroll
            for (int q = 0; q < 8; ++q) { S1 += st[(q * 64 + t) * 2]; S2 += st[(q * 64 + t) * 2 + 1]; }
            const float mu = S1 * (1.f / 128.f), var = S2 * (1.f / 128.f) - mu * mu, rstd = rsqrtf(fmaxf(var, 0.f) + 1e-6f);
            const size_t oix = (size_t)(tok0 + t) * 512 + h * 128 + 16 * w + 4 * fq; const u32x2 oq = opc[tt]; const f32x4 g4 = *(const f32x4*)(ng + h * 128 + 16 * w + 4 * fq);
            const float o0 = sigm(bf_lo(oq.x)) * (hv[tt][0] - mu) * rstd * g4.x, o1 = sigm(bf_hi(oq.x)) * (hv[tt][1] - mu) * rstd * g4.y,
                        o2 = sigm(bf_lo(oq.y)) * (hv[tt][2] - mu) * rstd * g4.z, o3 = sigm(bf_hi(oq.y)) * (hv[tt][3] - mu) * rstd * g4.w;
            const u32x2 ow = {pk2(o0, o1), pk2(o2, o3)}; *(u32x2*)(MOo + oix) = ow; }
#pragma unroll
        for (int i = 0; i < 8; ++i) Cacc[i] = Cacc[i] * wprev;
        Nacc = Nacc * wprev;
#pragma unroll
        for (int pp = 0; pp < 2; ++pp) {
            const f32x4 wla = *(const f32x4*)(gwv + 256 + 32 * pp + 8 * fq), wlb = *(const f32x4*)(gwv + 256 + 32 * pp + 8 * fq + 4);
            const float wl[8] = {wla.x, wla.y, wla.z, wla.w, wlb.x, wlb.y, wlb.z, wlb.w};
            const u32x4 vq = *(const u32x4*)(Vt + (16 * w + fr) * 72 + 32 * pp + 8 * fq);
            const u32x4 av = {pk2(bf_lo(vq.x) * wl[0], bf_hi(vq.x) * wl[1]), pk2(bf_lo(vq.y) * wl[2], bf_hi(vq.y) * wl[3]), pk2(bf_lo(vq.z) * wl[4], bf_hi(vq.z) * wl[5]), pk2(bf_lo(vq.w) * wl[6], bf_hi(vq.w) * wl[7])};
            u32x4 nv = {pk2(wl[0], wl[1]), pk2(wl[2], wl[3]), pk2(wl[4], wl[5]), pk2(wl[6], wl[7])};
            if (fr != 0) nv = (u32x4){0u, 0u, 0u, 0u};
            const bf16x8 afr = __builtin_bit_cast(bf16x8, av), nfr = __builtin_bit_cast(bf16x8, nv);
#pragma unroll
            for (int dt = 0; dt < 8; ++dt) Cacc[dt] = MFMA16(afr, ld8(Kt + (16 * dt + fr) * 72 + 32 * pp + 8 * fq), Cacc[dt]);
            Nacc = MFMA16(nfr, ld8(Kt + (16 * w + fr) * 72 + 32 * pp + 8 * fq), Nacc);
        }
#pragma unroll
        for (int dt = 0; dt < 8; ++dt)
#pragma unroll
            for (int j = 0; j < 4; ++j) Cb[(16 * w + 4 * fq + j) * 136 + 16 * dt + fr] = (bf16_t)f2bf(Cacc[dt][j]);
        if (fq == 0) Cb[128 * 136 + 16 * w + fr] = (bf16_t)f2bf(Nacc[0]);
        m_prev = m_new;
    }
    __syncthreads();
}
#ifndef FUSE_RMS
#define FUSE_RMS 0
#endif
#ifndef GSPLIT
#define GSPLIT 4
#endif
#ifndef NSA_EARLY
#define NSA_EARLY 0
#endif
#ifndef FAST_BAR
#define FAST_BAR 0
#endif
#ifndef NSA_CMP_SB
#define NSA_CMP_SB 1
#endif
#ifndef NSA_PART
#define NSA_PART 7
#endif
__device__ __forceinline__ void nsa_loadk(const bf16_t* Kb, int key0, bf16x8 (&kf)[2][2], int fr, int fq) {
#pragma unroll
    for (int s2 = 0; s2 < 2; ++s2)
#pragma unroll
        for (int kk = 0; kk < 2; ++kk) kf[s2][kk] = ld8(Kb + (size_t)(key0 + 16 * s2 + fr) * 128 + 32 * kk + 8 * fq);
}
__device__ __forceinline__ void nsa_step(const bf16_t* Kb, const bf16_t* VTb, int key0, int pk, bf16x8 (&kf)[2][2], const bf16x8 (&qf)[4][2], const float (&slope)[4],
                                         int lo, int t, bool on, float (&m)[4], float (&ls)[4], f32x4 (&Ob)[4][4], int fr, int fq) {
    bf16x8 kn[2][2], vf[4];
    nsa_loadk(Kb, pk, kn, fr, fq);
#pragma unroll
    for (int dt = 0; dt < 4; ++dt) { const bf16_t* vp = VTb + (size_t)(16 * dt + fr) * 2048 + key0 + 4 * fq; vf[dt] = ld44(vp, vp + 16); }
    const int kb = key0 + 4 * fq;
    float pen[8];
#pragma unroll
    for (int j = 0; j < 4; ++j) { const int k0 = kb + j, k1 = kb + 16 + j;
        pen[j] = (on && k0 >= lo && k0 <= t) ? 0.f : -__builtin_inff(); pen[4 + j] = (on && k1 >= lo && k1 <= t) ? 0.f : -__builtin_inff(); }
    const float tk = (float)(t - kb);
#pragma unroll
    for (int h = 0; h < 4; ++h) {
        f32x4 S0 = (f32x4){0.f, 0.f, 0.f, 0.f}, S1 = (f32x4){0.f, 0.f, 0.f, 0.f};
        S0 = MFMA16(kf[0][0], qf[h][0], S0); S0 = MFMA16(kf[0][1], qf[h][1], S0);
        S1 = MFMA16(kf[1][0], qf[h][0], S1); S1 = MFMA16(kf[1][1], qf[h][1], S1);
        const float base = -slope[h] * tk; float sc[8], mx = -1e30f;
#pragma unroll
        for (int j = 0; j < 4; ++j) {
            sc[j] = __builtin_fmaf(S0[j], 0.18033688011112042f, __builtin_fmaf(slope[h], (float)j, base)) + pen[j];
            sc[4 + j] = __builtin_fmaf(S1[j], 0.18033688011112042f, __builtin_fmaf(slope[h], (float)(16 + j), base)) + pen[4 + j];
            mx = fmaxf(mx, fmaxf(sc[j], sc[4 + j])); }
        mx = fq_max(mx);
        const float mn = fmaxf(m[h], mx), al = __builtin_amdgcn_exp2f(m[h] - mn); m[h] = mn;
        float ps = 0.f;
#pragma unroll
        for (int j = 0; j < 8; ++j) { sc[j] = __builtin_amdgcn_exp2f(sc[j] - mn); ps += sc[j]; }
        ls[h] = ls[h] * al + ps;
        const u32x4 pw = {pk2(sc[0], sc[1]), pk2(sc[2], sc[3]), pk2(sc[4], sc[5]), pk2(sc[6], sc[7])};
        const bf16x8 pf = __builtin_bit_cast(bf16x8, pw);
#pragma unroll
        for (int dt = 0; dt < 4; ++dt) { Ob[h][dt] = Ob[h][dt] * al; Ob[h][dt] = MFMA16(vf[dt], pf, Ob[h][dt]); }
        if (h & 1) __builtin_amdgcn_sched_barrier(0);
    }
#pragma unroll
    for (int s2 = 0; s2 < 2; ++s2)
#pragma unroll
        for (int kk = 0; kk < 2; ++kk) kf[s2][kk] = kn[s2][kk];
}
__device__ __forceinline__ void nsa_tile(const KP& p, int l, int witem, unsigned char* lds, int wv, int dup) {
    unsigned char* ws_ = PWS(); const int lane = lane_id_v(), fr = lane & 15, fq = lane >> 4;
    const int qt = witem & 127, g = (witem >> 7) & 1, b = witem >> 8, t0 = qt * 16, tok0 = b * 2048 + t0, t = t0 + fr, jt = t0 >> 6;
    float* ol = (float*)(lds + wv * 16384) + lane;
    bf16_t* NQ = (bf16_t*)(ws_ + WS_Z + 2 * ZSLOT); const float* gp = (const float*)(ws_ + WS_SM) + (size_t)(tok0 + fr) * 32 + 8 + g * 12;
    const bf16_t* NKb = (const bf16_t*)(ws_ + WS_NK);
    float slope[4];
#pragma unroll
    for (int h = 0; h < 4; ++h) slope[h] = exp2f(-(float)(g * 4 + h + 1));
    float impv[8];
#pragma unroll
    for (int i = 0; i < 8; ++i) impv[i] = 0.f;
    if (NSA_PART & 1) {
        const bf16_t* Kc = (const bf16_t*)(ws_ + WS_KCMP) + (size_t)(b * 2 + g) * 128 * 64; const bf16_t* VcT = (const bf16_t*)(ws_ + WS_VCMP) + (size_t)(b * 2 + g) * 64 * 128;
        const int srcl = (lane + 48) & 63;
#pragma unroll 1
        for (int h = 0; h < 4; ++h) {
            const float slope_h = exp2f(-(float)(g * 4 + h + 1));
            const bf16x8 qh0 = ld8(NQ + (size_t)(tok0 + fr) * 512 + (g * 4 + h) * 64 + 8 * fq), qh1 = ld8(NQ + (size_t)(tok0 + fr) * 512 + (g * 4 + h) * 64 + 32 + 8 * fq);
            f32x4 S[8]; float mx = -1e30f;
#pragma unroll
            for (int st = 0; st < 8; ++st) { f32x4 a = (f32x4){0.f, 0.f, 0.f, 0.f};
                if (NSA_CMP_SB && (st & 1) == 0) __builtin_amdgcn_sched_barrier(0);
                a = MFMA16(ld8(Kc + (size_t)(16 * st + fr) * 64 + 8 * fq), qh0, a); a = MFMA16(ld8(Kc + (size_t)(16 * st + fr) * 64 + 32 + 8 * fq), qh1, a);
#pragma unroll
                for (int j = 0; j < 4; ++j) { const int c = 16 * st + 4 * fq + j; const bool ok = (c < 127) && (16 * c + 31 <= t);
                    a[j] = ok ? a[j] * 0.125f - slope_h * ((float)t - (16.f * (float)c + 15.5f)) : -1e30f; mx = fmaxf(mx, a[j]); }
                S[st] = a; }
            mx = fq_max(mx);
            float sum = 0.f;
#pragma unroll
            for (int st = 0; st < 8; ++st)
#pragma unroll
                for (int j = 0; j < 4; ++j) { S[st][j] = S[st][j] > -1e29f ? __expf(S[st][j] - mx) : 0.f; sum += S[st][j]; }
            sum = fq_sum(sum);
            const float inv = sum > 0.f ? 1.f / sum : 0.f;
#pragma unroll
            for (int st = 0; st < 8; ++st) { S[st] = S[st] * inv;
                const float a3 = __shfl(S[st][3], srcl); const float b3 = st > 0 ? __shfl(S[st - 1][3], srcl) : 0.f;
                impv[st] += (S[st][0] + S[st][1]) + (S[st][2] + S[st][3]) + (fq > 0 ? a3 : b3); }
            f32x4 Oc[4];
#pragma unroll
            for (int dt = 0; dt < 4; ++dt) Oc[dt] = (f32x4){0.f, 0.f, 0.f, 0.f};
#pragma unroll
            for (int pp = 0; pp < 4; ++pp) { if (NSA_CMP_SB) __builtin_amdgcn_sched_barrier(0); const bf16x8 pf = pack8(S[2 * pp], S[2 * pp + 1]);
#pragma unroll
                for (int dt = 0; dt < 4; ++dt) { const bf16_t* vp = VcT + (size_t)(16 * dt + fr) * 128 + 32 * pp + 4 * fq; Oc[dt] = MFMA16(ld44(vp, vp + 16), pf, Oc[dt]); } }
            const float g0 = sigm(gp[h * 3 + 0]);
#pragma unroll
            for (int dt = 0; dt < 4; ++dt)
#pragma unroll
                for (int j = 0; j < 4; ++j) ol[((h * 4 + dt) * 4 + j) * 64] = g0 * Oc[dt][j];
            __builtin_amdgcn_sched_barrier(0);
        }
    }
    unsigned selq = 1u, umask = 1u;
    if (NSA_PART & 2) {
        float val[8];
#pragma unroll
        for (int st = 0; st < 8; ++st) { const int J = 4 * st + fq; val[st] = J > jt ? -1e30f : ((J == 0 || J == jt || J == jt - 1) ? 1e4f : impv[st]); }
        int rank[8];
#pragma unroll
        for (int st = 0; st < 8; ++st) rank[st] = 0;
#pragma unroll
        for (int sq = 0; sq < 4; ++sq)
#pragma unroll
            for (int s2 = 0; s2 < 8; ++s2) { const float o = __shfl(val[s2], fr + 16 * sq); const int J2 = 4 * s2 + sq;
#pragma unroll
                for (int st = 0; st < 8; ++st) { const int J = 4 * st + fq; rank[st] += (o > val[st] || (o == val[st] && J2 < J)) ? 1 : 0; } }
        unsigned mk = 0u;
#pragma unroll
        for (int st = 0; st < 8; ++st) { const int J = 4 * st + fq; if (rank[st] < 8 && J <= jt) mk |= 1u << J; }
        mk = fq_or(mk);
        selq = mk; unsigned um = mk;
        um |= __shfl_xor(um, 1); um |= __shfl_xor(um, 2); um |= __shfl_xor(um, 4); um |= __shfl_xor(um, 8);
        umask = __builtin_amdgcn_readfirstlane(um);
    }
    __builtin_amdgcn_sched_barrier(0);
#pragma unroll
    for (int h = 0; h < 4; ++h) slope[h] *= 1.4426950408889634f;
    bf16x8 qf[4][2];
#pragma unroll
    for (int h = 0; h < 4; ++h)
#pragma unroll
        for (int kk = 0; kk < 2; ++kk) qf[h][kk] = ld8(NQ + (size_t)(tok0 + fr) * 512 + (g * 4 + h) * 64 + 32 * kk + 8 * fq);
#pragma unroll 1
    for (int br = 1; br < 3; ++br) { if (!(NSA_PART & 4)) break;
        const bf16_t* Kb = NKb + (size_t)(2 * br) * ((size_t)T * 128) + (size_t)b * 2048 * 128 + g * 64;
        const bf16_t* VTb = NKb + (size_t)(2 * br + 1) * ((size_t)T * 128) + (size_t)(b * 2 + g) * 64 * 2048;
        float m[4] = {-1e30f, -1e30f, -1e30f, -1e30f}, ls[4] = {0.f, 0.f, 0.f, 0.f}; f32x4 Ob[4][4];
#pragma unroll
        for (int h = 0; h < 4; ++h)
#pragma unroll
            for (int dt = 0; dt < 4; ++dt) Ob[h][dt] = (f32x4){0.f, 0.f, 0.f, 0.f};
        {
            unsigned mk = umask; int key0;
            if (br == 1) { key0 = 64 * __builtin_ctz(mk); mk &= mk - 1; }
            else { key0 = t0 - 511; key0 = key0 < 0 ? 0 : (key0 & ~31); }
            bf16x8 kf[2][2]; nsa_loadk(Kb, key0, kf, fr, fq);
#pragma unroll 1
            while (key0 >= 0) {
                int nk;
                if (br == 1) { if ((key0 & 32) == 0 && key0 + 32 <= t0 + 15) nk = key0 + 32; else if (mk) { nk = 64 * __builtin_ctz(mk); mk &= mk - 1; } else nk = -1; }
                else nk = (key0 + 32 <= t0 + 15) ? key0 + 32 : -1;
                const bool on = br == 1 ? ((selq >> (key0 >> 6)) & 1u) : true;
                nsa_step(Kb, VTb, key0, nk >= 0 ? nk : key0, kf, qf, slope, br == 1 ? 0 : t - 511, t, on, m, ls, Ob, fr, fq);
                key0 = nk;
            }
        }
#pragma unroll
        for (int h = 0; h < 4; ++h) { float lt = ls[h]; lt = fq_sum(lt); const float sc = sigm(gp[h * 3 + br]) / lt;
#pragma unroll
            for (int dt = 0; dt < 4; ++dt) {
                if (br == 1) {
#pragma unroll
                    for (int j = 0; j < 4; ++j) ol[((h * 4 + dt) * 4 + j) * 64] += sc * Ob[h][dt][j];
                } else {
                    float o[4];
#pragma unroll
                    for (int j = 0; j < 4; ++j) o[j] = ol[((h * 4 + dt) * 4 + j) * 64] + sc * Ob[h][dt][j];
                    const u32x2 w = {pk2(o[0], o[1]), pk2(o[2], o[3])}; *(u32x2*)((dup ? (bf16_t*)(ws_ + WS_GAB) : NQ) + (size_t)(tok0 + fr) * 512 + (g * 4 + h) * 64 + 16 * dt + 4 * fq) = w;
                } } }
    }
}

#define GEMM_RUN(GB, EPI, E, Aptr, Bptr, N_, K_) do { pg8::Gemm gg{(const bf16_t*)(Aptr), (const bf16_t*)(Bptr), T, (N_), (K_)}; pg8::StaticOrder SO; SO.init(T, (N_), gdim, bid); \
    if (EN & (GB)) pg8::gemm_phase<EPI, pg8::StaticOrder, true, true>((PG8_LAS unsigned char*)lds, gg, SO, E, wv); __syncthreads(); } while (0)

#define GEMM_RUN_SUB(GB, EPI, E, Aptr, Bptr, N_, K_, G_, C_) do { pg8::Gemm gg{(const bf16_t*)(Aptr), (const bf16_t*)(Bptr), T, (N_), (K_)}; pg8::StaticOrder SO; SO.init(T, (N_), (G_), (C_)); \
    if (EN & (GB)) pg8::gemm_phase<EPI, pg8::StaticOrder, true, true>((PG8_LAS unsigned char*)lds, gg, SO, E, wv); __syncthreads(); } while (0)
#define GEMM_RUN_PANEL(GB, EPI, E, Aptr, Bptr, N_, K_) do { pg8::Gemm gg{(const bf16_t*)(Aptr), (const bf16_t*)(Bptr), T, (N_), (K_)}; PanelOrder SO{bid, (N_) / 256}; \
    if (EN & (GB)) pg8::gemm_phase<EPI, PanelOrder, true, true>((PG8_LAS unsigned char*)lds, gg, SO, E, wv); __syncthreads(); if (threadIdx.x == 0) __threadfence(); __syncthreads(); } while (0)
template <int EN> __global__ void __launch_bounds__(512, 2) mega_fwd(KP p) {
    extern __shared__ __attribute__((aligned(16))) unsigned char lds[];
    const int wv0 = __builtin_amdgcn_readfirstlane(threadIdx.x >> 6);
    if (threadIdx.x == 0) { unsigned long long* tab = (unsigned long long*)(lds + TAB_OFF);
        tab[0] = (unsigned long long)p.in[0]; tab[1] = (unsigned long long)p.in[1]; tab[2] = (unsigned long long)p.in[2]; tab[3] = (unsigned long long)p.in[3]; tab[4] = (unsigned long long)p.in[4];
        tab[5] = (unsigned long long)p.in[5]; tab[6] = (unsigned long long)p.in[6]; tab[7] = (unsigned long long)p.in[7]; tab[8] = (unsigned long long)p.in[8]; tab[9] = (unsigned long long)p.in[9];
        tab[10] = (unsigned long long)p.in[10]; tab[11] = (unsigned long long)p.in[11]; tab[12] = (unsigned long long)p.in[12]; tab[13] = (unsigned long long)p.in[13]; tab[14] = (unsigned long long)p.in[14];
        tab[15] = (unsigned long long)p.in[15]; tab[16] = (unsigned long long)p.in[16]; tab[17] = (unsigned long long)p.in[17]; tab[18] = (unsigned long long)p.in[18]; tab[19] = (unsigned long long)p.in[19];
        tab[20] = (unsigned long long)p.in[20]; tab[21] = (unsigned long long)p.in[21]; tab[22] = (unsigned long long)p.in[22]; tab[23] = (unsigned long long)p.in[23]; tab[24] = (unsigned long long)p.in[24];
        tab[25] = (unsigned long long)p.in[25]; tab[26] = (unsigned long long)p.in[26]; tab[27] = (unsigned long long)p.in[27]; tab[28] = (unsigned long long)p.out; tab[29] = (unsigned long long)p.ws; }
    const int ph_lo = p.lo, ph_hi = p.hi; unsigned nbar = 0;
    __syncthreads();
    for (int ph = ph_lo; ph < ph_hi; ++ph) {
        const int bid = blockIdx.x, gdim = gridDim.x, wv = wv0;
        const bool fuse_rms = FUSE_RMS && gdim == 256;
        if (fuse_rms && (ph == NPHASE - 1 || ph == 7 || ph == 10 || ph == 16)) continue;
        if (ph == 0) { if (EN & 1) prep_phase(p, lds, wv, bid, gdim); }
        else if (ph == NPHASE - 1) rms_phase(POUT(), PIN(27), nullptr, nullptr, nullptr, POUT(), wv, bid, gdim);
        else {
            const int l = (ph - 1) / 9, sub = (ph - 1) % 9;
#ifdef PROBE_REP
            for (int rep = 0; rep < (((PROBE_REP) >> sub) & 1) + 1; ++rep) {
#else
            {
#endif
            unsigned char* wb = PWS() + WS_W + (size_t)l * W_LAYER;
            const float* mod = (const float*)(PWS() + WS_MOD) + (size_t)l * 32 * 6144;
            const float* xin = l == 0 ? PIN(0) : POUT();
            if (sub == 0) rms_phase(xin, PIN(2) + l * 1024, mod, mod + 1024, (bf16_t*)(PWS() + WS_H), nullptr, wv, bid, gdim);
            else if (sub == 1) { EpiIn E{(bf16_t*)(PWS() + WS_Z), (bf16_t*)(PWS() + WS_NK), (float*)(PWS() + WS_SM)}; GEMM_RUN(32, EpiIn, E, PWS() + WS_H, wb + WO_IN, 4608, 1024); }
            else if (sub == 2) {
                const int dup = 0;
                if (gdim == 256) {
                    if (bid < 128) { if (EN & 2) mlstm_item(p, l, bid, lds, wv, dup); }
                    else { const int jb = bid - 128;
                        if (EN & 8) compress_wave(p, l, jb * 8 + wv, wv);
                        if (EN & 4) { gmlp_load_w(l, jb & 3, lds, wv); for (int k = 0; k < 16; ++k) gmlp_item(p, l, jb + 128 * k, lds, wv, dup, 1); } }
                } else
                for (int it = bid; it < 128 + 2048 + 128; it += gdim) {
                    if (it < 128) { if (EN & 2) mlstm_item(p, l, it, lds, wv, dup); }
                    else if (it < 128 + 2048) { if (EN & 4) gmlp_item(p, l, it - 128, lds, wv, dup, 0); }
                    else { if (EN & 8) { compress_wave(p, l, (it - 128 - 2048) * 8 + wv, wv); } }
                }
                __syncthreads();
                if (gdim == 256 && bid >= 128) {
                    EpiGate E{(bf16_t*)(PWS() + WS_GAB), (bf16_t*)(PWS() + WS_GC), 0}; GEMM_RUN_SUB(64, EpiGate, E, PWS() + WS_H, wb + WO_IN + (size_t)4608 * 1024 * 2, GSPLIT * 256, 1024, 128, bid - 128);
                    if (NSA_EARLY > 0) grid_bar((unsigned*)PWS() + 64, 128u * (unsigned)(l + 1));
                    for (int bi = bid - 128; bi < NSA_EARLY; bi += 128) nsa_tile(p, l, ((bi & ~15) | (((bi & 15) + 4 * (bi >> 8)) & 15)) * 8 + wv, lds, wv, 0);
                    __syncthreads(); }
            }
            else if (sub == 3) {
                #ifdef PROBE_DUP
                for (int dup = ((PROBE_DUP) >> 3) & 1; dup >= 0; --dup)
#else
                const int dup = 0;
#endif
                const int vb = (gdim & 7) == 0 ? (bid & 7) * (gdim >> 3) + (bid >> 3) : bid;
                if (EN & 16) for (int bi = (gdim == 256 ? NSA_EARLY : 0) + vb; bi < 1024; bi += gdim) nsa_tile(p, l, ((bi & ~15) | (((bi & 15) + 4 * (bi >> 8)) & 15)) * 8 + wv, lds, wv, dup);
                __syncthreads();
                if (gdim == 256) { EpiGate E{(bf16_t*)(PWS() + WS_GAB), (bf16_t*)(PWS() + WS_GC), GSPLIT}; GEMM_RUN(64, EpiGate, E, PWS() + WS_H, wb + WO_IN + (size_t)(4608 + GSPLIT * 256) * 1024 * 2, 3072 - GSPLIT * 256, 1024); }
                else { EpiGate E{(bf16_t*)(PWS() + WS_GAB), (bf16_t*)(PWS() + WS_GC), 0}; GEMM_RUN(64, EpiGate, E, PWS() + WS_H, wb + WO_IN + (size_t)4608 * 1024 * 2, 3072, 1024); }
            }
            else if (sub == 4) {
                { EpiUp E{(bf16_t*)(PWS() + WS_MRG), (const bf16_t*)(PWS() + WS_GAB), 1}; GEMM_RUN(128, EpiUp, E, PWS() + WS_Z, wb + WO_UPA, 1024, 512); }
                { EpiUp E{(bf16_t*)(PWS() + WS_MRG), (const bf16_t*)(PWS() + WS_GAB) + (size_t)T * 1024, 0}; GEMM_RUN(128, EpiUp, E, PWS() + WS_Z + 1 * ZSLOT, wb + WO_UPB, 1024, 512); }
                { EpiUp E{(bf16_t*)(PWS() + WS_MRG), (const bf16_t*)(PWS() + WS_GC), 0}; GEMM_RUN(128, EpiUp, E, PWS() + WS_Z + 2 * ZSLOT, wb + WO_UPC, 1024, 512); }
            }
            else if (sub == 5) { EpiRes E{xin, POUT(), mod + 2048};
                if (fuse_rms) { GEMM_RUN_PANEL(256, EpiRes, E, PWS() + WS_MRG, wb + WO_OUT, 1024, 1024);
                    rms_rows(POUT(), PIN(3) + l * 1024, mod + 3072, mod + 4096, (bf16_t*)(PWS() + WS_H), nullptr, wv, 256 * bid, 256 * bid + 256); }
                else GEMM_RUN(256, EpiRes, E, PWS() + WS_MRG, wb + WO_OUT, 1024, 1024); }
            else if (sub == 6) rms_phase(POUT(), PIN(3) + l * 1024, mod + 3072, mod + 4096, (bf16_t*)(PWS() + WS_H), nullptr, wv, bid, gdim);
            else if (sub == 7) { EpiMlp1 E{(bf16_t*)(PWS() + WS_F)}; GEMM_RUN(512, EpiMlp1, E, PWS() + WS_H, wb + WO_M1, 4096, 1024); }
            else { EpiRes E{POUT(), POUT(), mod + 5120};
                if (fuse_rms) { GEMM_RUN_PANEL(256, EpiRes, E, PWS() + WS_F, wb + WO_M2, 1024, 4096);
                    if (l == 0) { const float* mod1 = (const float*)(PWS() + WS_MOD) + (size_t)32 * 6144; rms_rows(POUT(), PIN(2) + 1024, mod1, mod1 + 1024, (bf16_t*)(PWS() + WS_H), nullptr, wv, 256 * bid, 256 * bid + 256); }
                    else rms_rows(POUT(), PIN(27), nullptr, nullptr, nullptr, POUT(), wv, 256 * bid, 256 * bid + 256); }
                else GEMM_RUN(256, EpiRes, E, PWS() + WS_F, wb + WO_M2, 1024, 4096); }
            }
        }
        if (ph + 1 < ph_hi && !(fuse_rms && ph + 1 == NPHASE - 1)) {
            if (ph == ph_lo || !FAST_BAR) cg::this_grid().sync();
            else { ++nbar; grid_bar((unsigned*)PWS() + 128, (unsigned)gridDim.x * nbar); }
        }
    }
}

#ifndef MK_MULTI
#define MK_MULTI 0
#endif
#if MK_MULTI == 1
#define MAINK 992
#else
#define MAINK 1023
#endif
template <int EN> static void launch_plain(const KP& a, int grid, hipStream_t stream) {
    static bool attr = false;
    if (!attr) { (void)hipFuncSetAttribute((const void*)mega_fwd<EN>, hipFuncAttributeMaxDynamicSharedMemorySize, LDS_BYTES); attr = true; }
    hipLaunchKernelGGL(mega_fwd<EN>, dim3(grid), dim3(512), LDS_BYTES, stream, a);
}
extern "C" void kernel_launch(void* const* d_in, const int* in_sizes, int n_in, void* d_out, int out_size, void* d_ws, size_t ws_size, hipStream_t stream) {
    static int grid = 0;
    if (grid == 0) {
        if (n_in != 28 || out_size != T * DM || ws_size < WS_END) { fprintf(stderr, "kernel_launch: unexpected shapes n_in %d out %d ws %zu (need %zu)\n", n_in, out_size, ws_size, (size_t)WS_END); grid = -1; return; }
        int dev = 0, cus = 0, per_cu = 0;
        (void)hipGetDevice(&dev); (void)hipDeviceGetAttribute(&cus, hipDeviceAttributeMultiprocessorCount, dev);
        if (hipFuncSetAttribute((const void*)mega_fwd<MAINK>, hipFuncAttributeMaxDynamicSharedMemorySize, LDS_BYTES) != hipSuccess) { fprintf(stderr, "kernel_launch: hipFuncSetAttribute failed\n"); grid = -1; return; }
        if (hipOccupancyMaxActiveBlocksPerMultiprocessor(&per_cu, (const void*)mega_fwd<MAINK>, 512, LDS_BYTES) != hipSuccess || per_cu < 1) { fprintf(stderr, "kernel_launch: occupancy query says %d\n", per_cu); per_cu = 1; }
        (void)hipGetLastError();
        grid = cus * per_cu;
    }
    if (grid < 0) return;
    KP a{};
    for (int i = 0; i < 28; ++i) a.in[i] = (const float*)d_in[i];
    a.out = (float*)d_out; a.ws = (unsigned char*)d_ws;
#if MK_MULTI == 2
    for (int ph = 0; ph < NPHASE; ++ph) { a.lo = ph; a.hi = ph + 1; launch_plain<1023>(a, grid, stream); }
#elif MK_MULTI
    for (int ph = 0; ph < NPHASE; ++ph) { a.lo = ph; a.hi = ph + 1;
        const int sub = (ph == 0 || ph == NPHASE - 1) ? -1 : (ph - 1) % 9;
        if (ph == 0) launch_plain<1>(a, grid, stream);
        else if (sub == -1 || sub == 0 || sub == 6) launch_plain<0>(a, grid, stream);
        else if (sub == 2) { launch_plain<2>(a, grid, stream); launch_plain<4>(a, grid, stream); launch_plain<8>(a, grid, stream); }
        else if (sub == 3) { launch_plain<16>(a, grid, stream); launch_plain<992>(a, grid, stream); }
        else launch_plain<992>(a, grid, stream);
    }
#else
    a.lo = 0; a.hi = NPHASE;
    if (NSA_EARLY > 0 || FAST_BAR) (void)hipMemsetAsync(d_ws, 0, 4096, stream);
    void* args[] = {&a};
    hipError_t e = hipLaunchCooperativeKernel((const void*)mega_fwd<1023>, dim3(grid), dim3(512), args, LDS_BYTES, stream);
    if (e != hipSuccess) fprintf(stderr, "cooperative launch failed: %s (grid %d)\n", hipGetErrorString(e), grid);
#endif
}
```

```cpp
#define GSPLIT 4
#define EPI_SB 0
#include <hip/hip_runtime.h>
#include <hip/hip_cooperative_groups.h>
#include <cstdio>
#include <cstdint>
namespace cg = cooperative_groups;
namespace pg8 {
#define PG8_LAS __attribute__((address_space(3)))
typedef unsigned short bf16_t;
typedef short bf16x8 __attribute__((ext_vector_type(8)));
typedef float f32x4 __attribute__((ext_vector_type(4)));
typedef unsigned u32x4 __attribute__((ext_vector_type(4)));
constexpr int BM = 256, BK = 64, HALF = 128, HTB = HALF * BK * 2  , STAGE_BYTES = 8 * HTB, NXCD = 8, WGM = 8;

__host__ __device__ __forceinline__ int lds_byte(int r, int c) { const int st = (r >> 4) * 2 + (c >> 5), rr = r & 15, cc = c & 31, ob = rr * 64 + cc * 2; return st * 1024 + (ob ^ (((ob >> 9) & 1) << 5)); }
__host__ __device__ __forceinline__ void stage_rc(int b, int& R, int& C) { const int st = b / 1024, sb = b % 1024, swz = sb ^ (((sb >> 9) & 1) << 5); R = (st >> 1) * 16 + swz / 64; C = (st & 1) * 32 + (swz % 64) / 2; }
__host__ __device__ __forceinline__ int perm32(int rho) { const int n = rho >> 4, i = rho & 15; return 8 * (i >> 2) + 4 * n + (i & 3); }

struct Unit { int pm, pn; };
struct Gemm { const bf16_t* A; const bf16_t* Bt; int M, N, K; };

struct StaticOrder {
    int nM, nN, nwg, G, c;
    __host__ __device__ void init(int M, int N, int G_, int c_) { nM = M / BM; nN = N / BM; nwg = nM * nN; G = G_; c = c_; }
    __host__ __device__ bool next(int i, Unit& u) const {
        const long L = (long)i * G + c; if (L >= nwg) return false;
        int wgid = (int)L; { const int q = nwg / NXCD, r = nwg % NXCD, xcd = wgid % NXCD, off = wgid / NXCD; wgid = (xcd < r ? xcd * (q + 1) : r * (q + 1) + (xcd - r) * q) + off; }
        const int nig = WGM * nN, gid = wgid / nig, fm = gid * WGM, gsz = (nM - fm) < WGM ? (nM - fm) : WGM;
        u.pm = fm + ((wgid % nig) % gsz); u.pn = (wgid % nig) / gsz; return true;
    }
    __device__ __forceinline__ void a_ready(const Unit&) const {}
    __device__ __forceinline__ void done(const Unit&) const {}
};

__device__ __forceinline__ unsigned cvt_pk_bf16(float lo, float hi) { unsigned r; asm volatile("v_cvt_pk_bf16_f32 %0, %1, %2" : "=v"(r) : "v"(lo), "v"(hi)); return r; }
template <class Epi, class Sched, bool ALIGN_EPI = false, bool SP2 = false>
__device__ __forceinline__ void gemm_phase(PG8_LAS unsigned char* lds, const Gemm g, const Sched& S, const Epi& E, int wv_) {
    int lane; asm volatile("v_mbcnt_lo_u32_b32 %0, -1, 0\n\tv_mbcnt_hi_u32_b32 %0, -1, %0" : "=v"(lane)); const int wid = wv_, tid = wv_ * 64 + lane, wr = wid >> 2, wc = wid & 3, fr = lane & 15, fq = lane >> 4;
    const int K = g.K, nt = K / BK;
    unsigned voffA[2], voffB[2];
#pragma unroll
    for (int i = 0; i < 2; ++i) { int R, C; stage_rc(tid * 16 + i * 8192, R, C); const int Rb = Epi::PERM ? ((R & ~31) + perm32(R & 31)) : R;
        voffA[i] = (unsigned)(R * K + C) * 2u; voffB[i] = (unsigned)(Rb * K + C) * 2u; }
    const size_t kstep = (size_t)(BK * 2);
    const size_t hstep = (size_t)HALF * K * 2;
    const size_t tstep = 2 * hstep;
    const unsigned ldsw = (unsigned)wid * 1024u;
    const int aoff = lds_byte(wr * 64 + fr, fq * 8), boff = lds_byte(wc * 32 + fr, fq * 8);
#define PG8_SA(b, h) (((b) * 2 + (h)) * HTB)
#define PG8_SB(b, h) ((4 + (b) * 2 + (h)) * HTB)
#define PG8_STAGE(bufoff, gbase, voff) do { _Pragma("unroll") for (int _i = 0; _i < 2; ++_i) \
        __builtin_amdgcn_global_load_lds((const unsigned*)((const char*)(gbase) + (voff)[_i]), (PG8_LAS unsigned*)(lds + (bufoff) + ldsw + _i * 8192), 16, 0, 0); } while (0)
#define PG8_LDA(dst, b, h) do { _Pragma("unroll") for (int m = 0; m < 4; ++m) _Pragma("unroll") for (int k = 0; k < 2; ++k) dst[m][k] = *(const PG8_LAS bf16x8*)(lds + PG8_SA(b, h) + aoff + m * 2048 + k * 1024); } while (0)
#define PG8_LDB(dst, b, h) do { _Pragma("unroll") for (int n = 0; n < 2; ++n) _Pragma("unroll") for (int k = 0; k < 2; ++k) dst[n][k] = *(const PG8_LAS bf16x8*)(lds + PG8_SB(b, h) + boff + n * 2048 + k * 1024); } while (0)
#define PG8_MMA(ai, bj, At, Bt) do { __builtin_amdgcn_s_setprio(1); _Pragma("unroll") for (int m = 0; m < 4; ++m) _Pragma("unroll") for (int n = 0; n < 2; ++n) _Pragma("unroll") for (int k = 0; k < 2; ++k) \
        acc[ai][bj][m][n] = __builtin_amdgcn_mfma_f32_16x16x32_bf16(Bt[n][k], At[m][k], acc[ai][bj][m][n], 0, 0, 0); __builtin_amdgcn_s_setprio(0); } while (0)
#define PG8_WAIT_V(n) asm volatile("s_waitcnt vmcnt(" #n ")" ::: "memory")
#define PG8_WAIT_L(n) asm volatile("s_waitcnt lgkmcnt(" #n ")" ::: "memory")
#define PG8_BAR __builtin_amdgcn_s_barrier()
#define PG8_SCHED __builtin_amdgcn_sched_barrier(0)
    Unit cur, nxt; int ui = 0;
    if (!S.next(0, cur)) return;
    f32x4 acc[2][2][4][2];
#pragma unroll
    for (int a = 0; a < 2; ++a)
#pragma unroll
        for (int b = 0; b < 2; ++b)
#pragma unroll
            for (int m = 0; m < 4; ++m)
#pragma unroll
                for (int n = 0; n < 2; ++n) acc[a][b][m][n] = (f32x4){0.f, 0.f, 0.f, 0.f};
    bf16x8 At[4][2], B0[2][2], B1[2][2];
    const char* cA = (const char*)g.A + (size_t)cur.pm * tstep; const char* cB = (const char*)g.Bt + (size_t)cur.pn * tstep;
    S.a_ready(cur);
    if constexpr (SP2) {
        PG8_STAGE(PG8_SB(0, 0), cB, voffB); PG8_STAGE(PG8_SB(0, 1), cB + hstep, voffB); PG8_STAGE(PG8_SA(0, 0), cA, voffA); PG8_STAGE(PG8_SA(0, 1), cA + hstep, voffA);
        if (wr == 1) PG8_BAR;
        PG8_WAIT_V(2); PG8_BAR;
        PG8_STAGE(PG8_SB(1, 0), cB + kstep, voffB); PG8_STAGE(PG8_SA(1, 0), cA + kstep, voffA); PG8_STAGE(PG8_SB(1, 1), cB + hstep + kstep, voffB);
        PG8_WAIT_V(6); PG8_BAR;
    } else {
        PG8_STAGE(PG8_SB(0, 0), cB, voffB); PG8_STAGE(PG8_SA(0, 0), cA, voffA); PG8_STAGE(PG8_SB(0, 1), cB + hstep, voffB); PG8_STAGE(PG8_SA(0, 1), cA + hstep, voffA);
        if (wr == 1) PG8_BAR;
        PG8_WAIT_V(4); PG8_BAR;
        PG8_STAGE(PG8_SB(1, 0), cB + kstep, voffB); PG8_STAGE(PG8_SA(1, 0), cA + kstep, voffA); PG8_STAGE(PG8_SB(1, 1), cB + hstep + kstep, voffB);
        PG8_WAIT_V(6); PG8_BAR;
    }
    for (;;) {
        const bool has_next = S.next(ui + 1, nxt);
        const char* nA = has_next ? (const char*)g.A + (size_t)nxt.pm * tstep : cA; const char* nB = has_next ? (const char*)g.Bt + (size_t)nxt.pn * tstep : cB;
        for (int t = 0; t < nt; t += 2) {
            const bool last = (t == nt - 2);
            const char* a1 = cA + (size_t)(t + 1) * kstep;
            const char* a2 = last ? nA : cA + (size_t)(t + 2) * kstep; const char* b2 = last ? nB : cB + (size_t)(t + 2) * kstep;
            const char* a3 = a2 + kstep; const char* b3 = b2 + kstep;
            if (last && has_next) S.a_ready(nxt);
            if constexpr (SP2) {
            PG8_LDB(B0, 0, 0); PG8_LDB(B1, 0, 1); PG8_SCHED; PG8_LDA(At, 0, 0); PG8_STAGE(PG8_SA(1, 1), a1 + hstep, voffA);
            PG8_WAIT_V(8); PG8_WAIT_L(0); PG8_BAR; PG8_MMA(0, 0, At, B0); PG8_MMA(0, 1, At, B1); PG8_BAR; PG8_SCHED;
            PG8_LDA(At, 0, 1); PG8_STAGE(PG8_SB(0, 0), b2, voffB); PG8_STAGE(PG8_SB(0, 1), b2 + hstep, voffB); PG8_STAGE(PG8_SA(0, 0), a2, voffA);
            PG8_WAIT_V(8); PG8_WAIT_L(0); PG8_BAR; PG8_MMA(1, 0, At, B0); PG8_MMA(1, 1, At, B1); PG8_BAR; PG8_SCHED;
            PG8_LDB(B0, 1, 0); PG8_LDB(B1, 1, 1); PG8_SCHED; PG8_LDA(At, 1, 0); PG8_STAGE(PG8_SA(0, 1), a2 + hstep, voffA);
            PG8_WAIT_V(8); PG8_WAIT_L(0); PG8_BAR; PG8_MMA(0, 0, At, B0); PG8_MMA(0, 1, At, B1); PG8_BAR; PG8_SCHED;
            PG8_LDA(At, 1, 1); PG8_STAGE(PG8_SB(1, 0), b3, voffB); PG8_STAGE(PG8_SB(1, 1), b3 + hstep, voffB); PG8_STAGE(PG8_SA(1, 0), a3, voffA);
            PG8_WAIT_V(8); PG8_WAIT_L(0); PG8_BAR; PG8_MMA(1, 0, At, B0); PG8_MMA(1, 1, At, B1); PG8_BAR; PG8_SCHED;
            } else {
            PG8_LDB(B0, 0, 0); PG8_SCHED; PG8_LDA(At, 0, 0); PG8_STAGE(PG8_SA(1, 1), a1 + hstep, voffA);
            PG8_WAIT_L(8); PG8_BAR; PG8_WAIT_L(0); PG8_MMA(0, 0, At, B0); PG8_BAR; PG8_SCHED;
            PG8_LDB(B1, 0, 1); PG8_STAGE(PG8_SB(0, 0), b2, voffB);
            PG8_BAR; PG8_WAIT_L(0); PG8_MMA(0, 1, At, B1); PG8_BAR;
            PG8_LDA(At, 0, 1); PG8_STAGE(PG8_SA(0, 0), a2, voffA);
            PG8_BAR; PG8_WAIT_L(0); PG8_MMA(1, 0, At, B0); PG8_BAR; PG8_SCHED;
            PG8_STAGE(PG8_SB(0, 1), b2 + hstep, voffB);
            PG8_WAIT_V(6); PG8_BAR; PG8_MMA(1, 1, At, B1); PG8_BAR;
            PG8_LDB(B0, 1, 0); PG8_SCHED; PG8_LDA(At, 1, 0); PG8_STAGE(PG8_SA(0, 1), a2 + hstep, voffA);
            PG8_WAIT_L(8); PG8_BAR; PG8_WAIT_L(0); PG8_MMA(0, 0, At, B0); PG8_BAR; PG8_SCHED;
            PG8_LDB(B1, 1, 1); PG8_STAGE(PG8_SB(1, 0), b3, voffB);
            PG8_BAR; PG8_WAIT_L(0); PG8_MMA(0, 1, At, B1); PG8_BAR;
            PG8_LDA(At, 1, 1); PG8_STAGE(PG8_SA(1, 0), a3, voffA);
            PG8_BAR; PG8_WAIT_L(0); PG8_MMA(1, 0, At, B0); PG8_BAR; PG8_SCHED;
            PG8_STAGE(PG8_SB(1, 1), b3 + hstep, voffB);
            PG8_WAIT_V(6); PG8_BAR; PG8_MMA(1, 1, At, B1); PG8_BAR;
            }
        }
        if constexpr (ALIGN_EPI) { if (wr == 0) PG8_BAR; }
        if constexpr (!Epi::AFTER_DRAIN) { E(acc, cur, wr, wc, fr, fq); S.done(cur); }
        if (!has_next) break;
#pragma unroll
        for (int a = 0; a < 2; ++a)
#pragma unroll
            for (int b = 0; b < 2; ++b)
#pragma unroll
                for (int m = 0; m < 4; ++m)
#pragma unroll
                    for (int n = 0; n < 2; ++n) acc[a][b][m][n] = (f32x4){0.f, 0.f, 0.f, 0.f};
        cur = nxt; cA = nA; cB = nB; ++ui;
        if constexpr (ALIGN_EPI) { if (wr == 1) PG8_BAR; }
    }
    PG8_WAIT_V(0);
    if constexpr (!ALIGN_EPI) { if (wr == 0) PG8_BAR; }
    PG8_BAR;
    if constexpr (Epi::AFTER_DRAIN) { E.fused(acc, cur, wr, wc, fr, fq, lds, wid, lane); S.done(cur); }
#undef PG8_SA
#undef PG8_SB
#undef PG8_STAGE
#undef PG8_LDA
#undef PG8_LDB
#undef PG8_MMA
#undef PG8_WAIT_V
#undef PG8_WAIT_L
#undef PG8_BAR
#undef PG8_SCHED
}
}
using pg8::bf16_t; using pg8::bf16x8; using pg8::f32x4; using pg8::u32x4;
typedef unsigned u32x2 __attribute__((ext_vector_type(2)));
typedef float f32x2v __attribute__((ext_vector_type(2)));

constexpr int T = 65536, DM = 1024, SEQ = 2048, NB = 32;
constexpr size_t MiB = 1u << 20;
constexpr size_t WS_MOD = 1 * MiB;
constexpr size_t WS_BIAS1 = 3 * MiB;
constexpr size_t WS_KCMP = 4 * MiB;
constexpr size_t WS_VCMP = 6 * MiB;
constexpr size_t WS_W = 8 * MiB;
constexpr size_t W_LAYER = 37 * MiB;
constexpr size_t WO_IN = 0, WO_UPA = 15 * MiB, WO_UPB = 16 * MiB, WO_UPC = 17 * MiB, WO_OUT = 18 * MiB, WO_M1 = 20 * MiB, WO_M2 = 28 * MiB,
                 WO_PK1 = 36 * MiB, WO_PV1 = 36 * MiB + 256 * 1024, WO_PK2 = 36 * MiB + 512 * 1024, WO_PV2 = 36 * MiB + 520 * 1024;
constexpr size_t WS_H = 82 * MiB;
constexpr size_t WS_Z = 210 * MiB;
constexpr size_t ZSLOT = 64 * MiB;
constexpr size_t WS_NK = 658 * MiB;
constexpr size_t NKSLOT = 16 * MiB;
constexpr size_t WS_SM = 754 * MiB;
constexpr size_t WS_GAB = 762 * MiB;
constexpr size_t WS_GC = WS_Z + 5 * ZSLOT;
constexpr size_t WS_MRG = WS_Z + 3 * ZSLOT;
constexpr size_t WS_F = WS_Z;
constexpr size_t WS_END = 1018 * MiB;
constexpr int LDS_BYTES = 135168;
constexpr int NPHASE = 20;

struct KP { const float* in[28]; float* out; unsigned char* ws; int lo, hi; };

typedef __bf16 bf16x2_hw __attribute__((ext_vector_type(2)));
__device__ __forceinline__ unsigned pk2(float lo, float hi) { const f32x2v v = {lo, hi}; const bf16x2_hw b = __builtin_convertvector(v, bf16x2_hw); return __builtin_bit_cast(unsigned, b); }
__device__ __forceinline__ unsigned f2bf(float f) { return pk2(f, f) & 0xffffu; }
__device__ __forceinline__ float bf_lo(unsigned u) { return __builtin_bit_cast(float, u << 16); }
__device__ __forceinline__ float bf_hi(unsigned u) { return __builtin_bit_cast(float, u & 0xffff0000u); }
__device__ __forceinline__ float bf1(bf16_t h) { return __builtin_bit_cast(float, ((unsigned)h) << 16); }
__device__ __forceinline__ float sigm(float x) { return __builtin_amdgcn_rcpf(1.f + __builtin_amdgcn_exp2f(-1.4426950408889634f * x)); }
__device__ __forceinline__ float gelu_t(float x) { const float x2 = x * x, u = x * __builtin_fmaf(x2, -0.10294324f, -2.3022082f); return x * __builtin_amdgcn_rcpf(1.f + __builtin_amdgcn_exp2f(u)); }
__device__ __forceinline__ float silu_(float x) { return x * __builtin_amdgcn_rcpf(1.f + __builtin_amdgcn_exp2f(-1.4426950408889634f * x)); }
__device__ __forceinline__ float wave_sum(float v) {
#pragma unroll
    for (int o = 1; o < 64; o <<= 1) v += __shfl_xor(v, o);
    return v;
}
__device__ __forceinline__ float wave_max(float v) {
#pragma unroll
    for (int o = 1; o < 64; o <<= 1) v = fmaxf(v, __shfl_xor(v, o));
    return v;
}
__device__ __forceinline__ bf16x8 ld8(const bf16_t* p) { return *(const bf16x8*)p; }
__device__ __forceinline__ bf16x8 ld44(const bf16_t* p0, const bf16_t* p1) { const u32x2 a = *(const u32x2*)p0, b = *(const u32x2*)p1; const u32x4 r = {a.x, a.y, b.x, b.y}; return __builtin_bit_cast(bf16x8, r); }
__device__ __forceinline__ bf16x8 pack8(f32x4 a, f32x4 b) { const u32x4 r = {pk2(a.x, a.y), pk2(a.z, a.w), pk2(b.x, b.y), pk2(b.z, b.w)}; return __builtin_bit_cast(bf16x8, r); }
__device__ __forceinline__ int lane_id_v() { int l; asm volatile("v_mbcnt_lo_u32_b32 %0, -1, 0\n\tv_mbcnt_hi_u32_b32 %0, -1, %0" : "=v"(l)); return l; }
constexpr int TAB_OFF = 132096;
__device__ __forceinline__ const float* ldsptr(int k) { extern __shared__ __attribute__((aligned(16))) unsigned char g_lds[];
    int koff = k * 8; asm volatile("" : "+v"(koff));
    const unsigned long long v = *(const unsigned long long*)(g_lds + TAB_OFF + koff);
    const unsigned lo = __builtin_amdgcn_readfirstlane((unsigned)v), hi = __builtin_amdgcn_readfirstlane((unsigned)(v >> 32));
    return (const float*)(((unsigned long long)hi << 32) | lo); }
#define PIN(k) ldsptr(k)
#define POUT() ((float*)ldsptr(28))
#define PWS() ((unsigned char*)ldsptr(29))
__device__ __forceinline__ void grid_bar(unsigned* cnt, unsigned target) {
    __syncthreads();
    if (threadIdx.x == 0) {
        __threadfence();
        __hip_atomic_fetch_add(cnt, 1u, __ATOMIC_RELAXED, __HIP_MEMORY_SCOPE_AGENT);
        while (__hip_atomic_load(cnt, __ATOMIC_RELAXED, __HIP_MEMORY_SCOPE_AGENT) < target) __builtin_amdgcn_s_sleep(1);
        __threadfence();
    }
    __syncthreads();
}
__device__ __forceinline__ void grid_bar2(unsigned* base, unsigned k, int bid, int gdim) {
    __syncthreads();
    if (threadIdx.x == 0) {
        __threadfence();
        unsigned* cg_ = base + 64 * (1 + (bid & 7)); const unsigned per = (unsigned)(gdim >> 3);
        const unsigned old = __hip_atomic_fetch_add(cg_, 1u, __ATOMIC_RELAXED, __HIP_MEMORY_SCOPE_AGENT);
        if (old + 1u == per * k) __hip_atomic_fetch_add(base, 1u, __ATOMIC_RELAXED, __HIP_MEMORY_SCOPE_AGENT);
        while (__hip_atomic_load(base, __ATOMIC_RELAXED, __HIP_MEMORY_SCOPE_AGENT) < 8u * k) __builtin_amdgcn_s_sleep(1);
        __threadfence();
    }
    __syncthreads();
}
__device__ __forceinline__ float fq_max(float v) { v = fmaxf(v, __shfl_xor(v, 16)); return fmaxf(v, __shfl_xor(v, 32)); }
__device__ __forceinline__ float fq_sum(float v) { v += __shfl_xor(v, 16); return v + __shfl_xor(v, 32); }
__device__ __forceinline__ unsigned fq_or(unsigned u) { u |= __shfl_xor(u, 16); return u | __shfl_xor(u, 32); }
#define MFMA16(a, b, c) __builtin_amdgcn_mfma_f32_16x16x32_bf16((a), (b), (c), 0, 0, 0)

#ifndef EPI_SB
#define EPI_SB 1
#endif
struct PanelOrder {
    int pm, n;
    __device__ __forceinline__ bool next(int i, pg8::Unit& u) const { if (i >= n) return false; u.pm = pm; u.pn = i; return true; }
    __device__ __forceinline__ void a_ready(const pg8::Unit&) const {}
    __device__ __forceinline__ void done(const pg8::Unit&) const {}
};
struct EpiIn {
    static constexpr bool PERM = true, AFTER_DRAIN = false;
    bf16_t* Z; bf16_t* NK; float* SM;
    __device__ __forceinline__ void operator()(const f32x4 (&acc)[2][2][4][2], const pg8::Unit& u, int wr, int wc, int fr, int fq) const {
        const int pn = u.pn, row0 = u.pm * 256 + wr * 64 + fr, cl = wc * 32 + 8 * fq;
        if (pn < 14) {
            const int slot = (0x2146530 >> (4 * (pn >> 1))) & 7;
            bf16_t* base = Z + (size_t)slot * ((size_t)T * 512) + (pn & 1) * 256 + cl;
            const bool act = pn < 4;
#pragma unroll
            for (int ai = 0; ai < 2; ++ai)
#pragma unroll
                for (int m = 0; m < 4; ++m) { bf16_t* rowp = base + (size_t)(row0 + ai * 128 + m * 16) * 512;
#pragma unroll
                    for (int bj = 0; bj < 2; ++bj) { f32x4 v0 = acc[ai][bj][m][0], v1 = acc[ai][bj][m][1];
                        if (act) { v0 = (f32x4){gelu_t(v0.x), gelu_t(v0.y), gelu_t(v0.z), gelu_t(v0.w)}; v1 = (f32x4){gelu_t(v1.x), gelu_t(v1.y), gelu_t(v1.z), gelu_t(v1.w)}; }
                        u32x4 w; w.x = pk2(v0.x, v0.y); w.y = pk2(v0.z, v0.w); w.z = pk2(v1.x, v1.y); w.w = pk2(v1.z, v1.w);
                        *(u32x4*)(rowp + bj * 128) = w; } }
        } else if (pn < 17) {
            if (pn > 14) {
                bf16_t* vt = NK + (size_t)((pn - 14) * 2 + 1) * ((size_t)T * 128) + (size_t)(cl >> 6) * 64 * 2048 + (size_t)(cl & 63) * 2048;
#pragma unroll
                for (int ai = 0; ai < 2; ++ai)
#pragma unroll
                    for (int m = 0; m < 4; ++m) { const int r = row0 + ai * 128 + m * 16; bf16_t* q = vt + (size_t)(r >> 11) * (2 * 64 * 2048) + (r & 2047);
                        const f32x4 v0 = acc[ai][1][m][0], v1 = acc[ai][1][m][1];
                        q[0 * 2048] = (bf16_t)f2bf(v0.x); q[1 * 2048] = (bf16_t)f2bf(v0.y); q[2 * 2048] = (bf16_t)f2bf(v0.z); q[3 * 2048] = (bf16_t)f2bf(v0.w);
                        q[4 * 2048] = (bf16_t)f2bf(v1.x); q[5 * 2048] = (bf16_t)f2bf(v1.y); q[6 * 2048] = (bf16_t)f2bf(v1.z); q[7 * 2048] = (bf16_t)f2bf(v1.w); }
            }
#pragma unroll
            for (int bj = 0; bj < 2; ++bj) { if (bj == 1 && pn > 14) continue; bf16_t* base = NK + (size_t)((pn - 14) * 2 + bj) * ((size_t)T * 128) + cl;
#pragma unroll
                for (int ai = 0; ai < 2; ++ai)
#pragma unroll
                    for (int m = 0; m < 4; ++m) { const f32x4 v0 = acc[ai][bj][m][0], v1 = acc[ai][bj][m][1];
                        u32x4 w; w.x = pk2(v0.x, v0.y); w.y = pk2(v0.z, v0.w); w.z = pk2(v1.x, v1.y); w.w = pk2(v1.z, v1.w);
                        *(u32x4*)(base + (size_t)(row0 + ai * 128 + m * 16) * 128) = w; } }
        } else {
            if (wc == 0) {
#pragma unroll
                for (int ai = 0; ai < 2; ++ai)
#pragma unroll
                    for (int m = 0; m < 4; ++m) { float* rp = SM + (size_t)(row0 + ai * 128 + m * 16) * 32 + 8 * fq;
                        *(f32x4*)rp = acc[ai][0][m][0]; *(f32x4*)(rp + 4) = acc[ai][0][m][1]; }
            }
        }
    }
};
struct EpiGate {
    static constexpr bool PERM = true, AFTER_DRAIN = false;
    bf16_t* GAB; bf16_t* GC; int pn0;
    __device__ __forceinline__ void operator()(const f32x4 (&acc)[2][2][4][2], const pg8::Unit& u, int wr, int wc, int fr, int fq) const {
        const int pn = u.pn + pn0, row0 = u.pm * 256 + wr * 64 + fr, cl = wc * 32 + 8 * fq, gi = pn >> 2;
        bf16_t* base = (gi < 2 ? GAB + (size_t)gi * ((size_t)T * 1024) : GC) + (pn & 3) * 256 + cl;
#pragma unroll
        for (int ai = 0; ai < 2; ++ai)
#pragma unroll
            for (int m = 0; m < 4; ++m) { bf16_t* rowp = base + (size_t)(row0 + ai * 128 + m * 16) * 1024;
#pragma unroll
                for (int bj = 0; bj < 2; ++bj) { const f32x4 v0 = acc[ai][bj][m][0], v1 = acc[ai][bj][m][1];
                    u32x4 w; w.x = pk2(sigm(v0.x), sigm(v0.y)); w.y = pk2(sigm(v0.z), sigm(v0.w)); w.z = pk2(sigm(v1.x), sigm(v1.y)); w.w = pk2(sigm(v1.z), sigm(v1.w));
                    *(u32x4*)(rowp + bj * 128) = w; } }
    }
};
struct EpiUp {
    static constexpr bool PERM = true, AFTER_DRAIN = false;
    bf16_t* MRG; const bf16_t* G; int first;
    __device__ __forceinline__ void operator()(const f32x4 (&acc)[2][2][4][2], const pg8::Unit& u, int wr, int wc, int fr, int fq) const {
        const int row0 = u.pm * 256 + wr * 64 + fr, c0 = u.pn * 256 + wc * 32 + 8 * fq;
#pragma unroll
        for (int ai = 0; ai < 2; ++ai)
#pragma unroll
            for (int m = 0; m < 4; ++m) { const size_t ro = (size_t)(row0 + ai * 128 + m * 16) * 1024 + c0;
#pragma unroll
                for (int bj = 0; bj < 2; ++bj) { const f32x4 v0 = acc[ai][bj][m][0], v1 = acc[ai][bj][m][1];
                    const u32x4 g = *(const u32x4*)(G + ro + bj * 128);
                    float o[8] = {bf_lo(g.x) * v0.x, bf_hi(g.x) * v0.y, bf_lo(g.y) * v0.z, bf_hi(g.y) * v0.w, bf_lo(g.z) * v1.x, bf_hi(g.z) * v1.y, bf_lo(g.w) * v1.z, bf_hi(g.w) * v1.w};
                    if (!first) { const u32x4 q = *(const u32x4*)(MRG + ro + bj * 128);
                        o[0] += bf_lo(q.x); o[1] += bf_hi(q.x); o[2] += bf_lo(q.y); o[3] += bf_hi(q.y); o[4] += bf_lo(q.z); o[5] += bf_hi(q.z); o[6] += bf_lo(q.w); o[7] += bf_hi(q.w); }
                    u32x4 w; w.x = pk2(o[0], o[1]); w.y = pk2(o[2], o[3]); w.z = pk2(o[4], o[5]); w.w = pk2(o[6], o[7]);
                    *(u32x4*)(MRG + ro + bj * 128) = w; } if (EPI_SB) __builtin_amdgcn_sched_barrier(0); }
    }
};
struct EpiRes {
    static constexpr bool PERM = true, AFTER_DRAIN = false;
    const float* xin; float* out; const float* gt;
    __device__ __forceinline__ void operator()(const f32x4 (&acc)[2][2][4][2], const pg8::Unit& u, int wr, int wc, int fr, int fq) const {
        const int row0 = u.pm * 256 + wr * 64 + fr, c0 = u.pn * 256 + wc * 32 + 8 * fq, b = (u.pm * 256) >> 11;
        const float* gp = gt + (size_t)b * 6144 + c0;
#pragma unroll
        for (int bj = 0; bj < 2; ++bj) { const f32x4 g0 = *(const f32x4*)(gp + bj * 128), g1 = *(const f32x4*)(gp + bj * 128 + 4);
#pragma unroll
            for (int ai = 0; ai < 2; ++ai)
#pragma unroll
                for (int m = 0; m < 4; ++m) { const size_t ro = (size_t)(row0 + ai * 128 + m * 16) * 1024 + c0 + bj * 128;
                    const f32x4 x0 = *(const f32x4*)(xin + ro), x1 = *(const f32x4*)(xin + ro + 4);
                    *(f32x4*)(out + ro) = x0 + g0 * acc[ai][bj][m][0];
                    *(f32x4*)(out + ro + 4) = x1 + g1 * acc[ai][bj][m][1]; if (EPI_SB && m == 3) __builtin_amdgcn_sched_barrier(0); } }
    }
};
struct EpiMlp1 {
    static constexpr bool PERM = true, AFTER_DRAIN = false;
    bf16_t* F;
    __device__ __forceinline__ void operator()(const f32x4 (&acc)[2][2][4][2], const pg8::Unit& u, int wr, int wc, int fr, int fq) const {
        const int row0 = u.pm * 256 + wr * 64 + fr, c0 = u.pn * 256 + wc * 32 + 8 * fq;
#pragma unroll
        for (int ai = 0; ai < 2; ++ai)
#pragma unroll
            for (int m = 0; m < 4; ++m) { bf16_t* rowp = F + (size_t)(row0 + ai * 128 + m * 16) * 4096 + c0;
#pragma unroll
                for (int bj = 0; bj < 2; ++bj) { f32x4 v0 = acc[ai][bj][m][0], v1 = acc[ai][bj][m][1];
                    v0 = __builtin_elementwise_max(v0, (f32x4){0.f, 0.f, 0.f, 0.f}); v1 = __builtin_elementwise_max(v1, (f32x4){0.f, 0.f, 0.f, 0.f}); v0 = v0 * v0; v1 = v1 * v1;
                    u32x4 w; w.x = pk2(v0.x, v0.y); w.y = pk2(v0.z, v0.w); w.z = pk2(v1.x, v1.y); w.w = pk2(v1.z, v1.w);
                    *(u32x4*)(rowp + bj * 128) = w; } }
    }
};
__device__ __forceinline__ int win_src_col(int n) { return n < 3072 ? n : n < 4352 ? n + 8 : n < 4360 ? n - 4352 + 3072 : n < 4384 ? n : n < 4608 ? -1 : n - 4608 + 4384; }
__device__ __forceinline__ void transpose_item(const float* src, int K, int Nsrc, bf16_t* dst, int mode, int item, int ntn, float* tile, int tid) {
    const int kb = item / ntn, nb = item % ntn, k0 = kb * 64, n0 = nb * 64;
    __syncthreads();
    { const int nn = tid & 63, kk0 = tid >> 6; int sc = n0 + nn; if (mode == 1) sc = win_src_col(sc);
#pragma unroll
      for (int i = 0; i < 8; ++i) { const int kk = kk0 + 8 * i; tile[kk * 65 + nn] = sc >= 0 ? src[(size_t)(k0 + kk) * Nsrc + sc] : 0.f; } }
    __syncthreads();
    { const int nn = tid >> 3, kc = tid & 7; const float* s = tile + (kc * 8) * 65 + nn;
      u32x4 o; o.x = pk2(s[0], s[65]); o.y = pk2(s[2 * 65], s[3 * 65]); o.z = pk2(s[4 * 65], s[5 * 65]); o.w = pk2(s[6 * 65], s[7 * 65]);
      *(u32x4*)(dst + (size_t)(n0 + nn) * K + k0 + kc * 8) = o; }
}
__device__ __forceinline__ void prep_phase(const KP& p, unsigned char* lds, int wv, int bid, int gdim) { unsigned char* ws_ = PWS(); const int tidx_ = wv * 64 + lane_id_v();
    const int tid = tidx_; float* fl = (float*)lds;
    constexpr int N_MOD = 96, N_B1 = 4, NITEMS = N_MOD + N_B1;
    float* modp = (float*)(ws_ + WS_MOD);
    for (int it = bid; it < NITEMS; it += gdim) {
        if (it < N_MOD) {
            const int l = it / 48, rem = it % 48, bq = rem / 12, n = (rem % 12) * 512 + tid;
            __syncthreads();
#pragma unroll
            for (int i = 0; i < 16; ++i) { const int idx = tid + 512 * i, k = idx >> 3, bb = idx & 7; fl[idx] = silu_(PIN(1)[(bq * 8 + bb) * 1024 + k]); }
            __syncthreads();
            const float* w = PIN(4) + (size_t)l * 1024 * 6144 + n;
            float a[8] = {0.f, 0.f, 0.f, 0.f, 0.f, 0.f, 0.f, 0.f};
#pragma unroll 4
            for (int k = 0; k < 1024; ++k) { const float wv = w[(size_t)k * 6144]; const f32x4 c0 = *(const f32x4*)(fl + k * 8), c1 = *(const f32x4*)(fl + k * 8 + 4);
                a[0] += c0.x * wv; a[1] += c0.y * wv; a[2] += c0.z * wv; a[3] += c0.w * wv; a[4] += c1.x * wv; a[5] += c1.y * wv; a[6] += c1.z * wv; a[7] += c1.w * wv; }
            const float bias = PIN(5)[l * 6144 + n];
#pragma unroll
            for (int bb = 0; bb < 8; ++bb) modp[((size_t)l * 32 + bq * 8 + bb) * 6144 + n] = a[bb] + bias;
            continue;
        }
        int r = it - N_MOD;
        {
            const int l = r >> 1, kv = r & 1; const float* pe = PIN(15 + kv) + l * 2048; const float* w1 = PIN(kv ? 19 : 17) + (size_t)l * 2048 * 64;
            const int n = tid & 63, part = tid >> 6; float a = 0.f;
            for (int k = part * 256; k < part * 256 + 256; ++k) a += pe[k] * w1[(size_t)k * 64 + n];
            __syncthreads(); fl[part * 64 + n] = a; __syncthreads();
            if (tid < 64) { float s = 0.f; for (int q = 0; q < 8; ++q) s += fl[q * 64 + tid]; ((float*)(ws_ + WS_BIAS1))[(l * 2 + kv) * 64 + tid] = s; }
        }
    }
    __syncthreads();
    {
        constexpr int J_IN = 16 * 240, J_UP = 8 * 32, J_OUT = 16 * 32, J_M1 = 16 * 128, J_M2 = 64 * 32, J_P1 = 32 * 2, J_P2 = 2;
        constexpr int PER_L = J_IN + 3 * J_UP + J_OUT + J_M1 + J_M2 + 2 * J_P1 + 2 * J_P2;
        float* scr = (float*)lds + wv * (64 * 33); const int lane = tid & 63;
        for (int it = bid * 8 + wv; it < 2 * PER_L; it += gdim * 8) {
            const int l = it / PER_L; int r = it % PER_L;
            unsigned char* wb = ws_ + WS_W + (size_t)l * W_LAYER;
            const float* W; bf16_t* WT; int K, Nsrc, nblk, mode = 0;
            if (r < J_IN) { W = PIN(6) + (size_t)l * 1024 * 7456; K = 1024; Nsrc = 7456; WT = (bf16_t*)(wb + WO_IN); nblk = 240; mode = 1; }
            else if ((r -= J_IN) < J_UP) { W = PIN(21) + (size_t)l * 512 * 1024; K = 512; Nsrc = 1024; WT = (bf16_t*)(wb + WO_UPA); nblk = 32; }
            else if ((r -= J_UP) < J_UP) { W = PIN(22) + (size_t)l * 512 * 1024; K = 512; Nsrc = 1024; WT = (bf16_t*)(wb + WO_UPB); nblk = 32; }
            else if ((r -= J_UP) < J_UP) { W = PIN(23) + (size_t)l * 512 * 1024; K = 512; Nsrc = 1024; WT = (bf16_t*)(wb + WO_UPC); nblk = 32; }
            else if ((r -= J_UP) < J_OUT) { W = PIN(24) + (size_t)l * 1024 * 1024; K = 1024; Nsrc = 1024; WT = (bf16_t*)(wb + WO_OUT); nblk = 32; }
            else if ((r -= J_OUT) < J_M1) { W = PIN(25) + (size_t)l * 1024 * 4096; K = 1024; Nsrc = 4096; WT = (bf16_t*)(wb + WO_M1); nblk = 128; }
            else if ((r -= J_M1) < J_M2) { W = PIN(26) + (size_t)l * 4096 * 1024; K = 4096; Nsrc = 1024; WT = (bf16_t*)(wb + WO_M2); nblk = 32; }
            else if ((r -= J_M2) < J_P1) { W = PIN(17) + (size_t)l * 2048 * 64; K = 2048; Nsrc = 64; WT = (bf16_t*)(wb + WO_PK1); nblk = 2; }
            else if ((r -= J_P1) < J_P1) { W = PIN(19) + (size_t)l * 2048 * 64; K = 2048; Nsrc = 64; WT = (bf16_t*)(wb + WO_PV1); nblk = 2; }
            else if ((r -= J_P1) < J_P2) { W = PIN(18) + (size_t)l * 64 * 64; K = 64; Nsrc = 64; WT = (bf16_t*)(wb + WO_PK2); nblk = 2; }
            else { r -= J_P2; W = PIN(20) + (size_t)l * 64 * 64; K = 64; Nsrc = 64; WT = (bf16_t*)(wb + WO_PV2); nblk = 2; }
            const int kb = r / nblk, nb = r % nblk, k0 = 64 * kb, n0 = 32 * nb;
            int sc = n0 + (lane & 31); if (mode == 1) sc = win_src_col(sc);
            const float* wsrc = W + (size_t)(k0 + (lane >> 5)) * Nsrc + (sc >= 0 ? sc : 0);
            __builtin_amdgcn_wave_barrier();
#pragma unroll 8
            for (int i = 0; i < 32; ++i) { const float v = wsrc[(size_t)(2 * i) * Nsrc]; scr[(2 * i + (lane >> 5)) * 33 + (lane & 31)] = sc >= 0 ? v : 0.f; }
            __builtin_amdgcn_wave_barrier();
            const int c = lane & 7;
#pragma unroll
            for (int j = 0; j < 4; ++j) { const int n = (lane >> 3) + 8 * j; const float* s = scr + (8 * c) * 33 + n;
                const u32x4 o = {pk2(s[0], s[33]), pk2(s[2 * 33], s[3 * 33]), pk2(s[4 * 33], s[5 * 33]), pk2(s[6 * 33], s[7 * 33])};
                *(u32x4*)(WT + (size_t)(n0 + n) * K + k0 + 8 * c) = o; }
        }
    }
    __syncthreads();
}

__device__ __forceinline__ void rms_phase(const float* xin, const float* gvec, const float* sh, const float* sc, bf16_t* outb, float* outf, int wv, int bid, int gdim) {
    const int tidx_ = wv * 64 + lane_id_v();
    const int lane = tidx_ & 63, gw = bid * 8 + (tidx_ >> 6), ngw = gdim * 8;
    constexpr int NR = 2;
    f32x4 gvv[4];
#pragma unroll
    for (int j = 0; j < 4; ++j) gvv[j] = *(const f32x4*)(gvec + 4 * (lane + 64 * j));
    for (int row = gw; row < T; row += NR * ngw) {
        f32x4 v[NR][4]; float s[NR]; int rr[NR];
#pragma unroll
        for (int q = 0; q < NR; ++q) { rr[q] = row + q * ngw < T ? row + q * ngw : row; const f32x4* xr = (const f32x4*)(xin + (size_t)rr[q] * 1024) + lane;
#pragma unroll
            for (int j = 0; j < 4; ++j) v[q][j] = xr[64 * j]; }
#pragma unroll
        for (int q = 0; q < NR; ++q) { s[q] = 0.f;
#pragma unroll
            for (int j = 0; j < 4; ++j) s[q] += (v[q][j].x * v[q][j].x + v[q][j].y * v[q][j].y) + (v[q][j].z * v[q][j].z + v[q][j].w * v[q][j].w); }
#pragma unroll
        for (int o = 1; o < 64; o <<= 1)
#pragma unroll
            for (int q = 0; q < NR; ++q) s[q] += __shfl_xor(s[q], o);
#pragma unroll
        for (int q = 0; q < NR; ++q) { const float r = rsqrtf(s[q] * (1.f / 1024.f) + 1e-6f); const int b = rr[q] >> 11; const bool wr_ = (q == 0) || (rr[q] != row);
#pragma unroll
            for (int j = 0; j < 4; ++j) { const int col = 4 * (lane + 64 * j); f32x4 y = v[q][j] * r * gvv[j];
                if (sc) y = y * (*(const f32x4*)(sc + (size_t)b * 6144 + col) + 1.f) + *(const f32x4*)(sh + (size_t)b * 6144 + col);
                if (wr_) { if (outb) { const u32x2 o = {pk2(y.x, y.y), pk2(y.z, y.w)}; *(u32x2*)(outb + (size_t)rr[q] * 1024 + col) = o; }
                           else *(f32x4*)(outf + (size_t)rr[q] * 1024 + col) = y; } } }
    }
}

__device__ __forceinline__ void rms_rows(const float* xin, const float* gvec, const float* sh, const float* sc, bf16_t* outb, float* outf, int wv, int rbeg, int rend) {
    const int lane = lane_id_v();
    for (int row = rbeg + wv; row < rend; row += 8) {
        const f32x4* xr = (const f32x4*)(xin + (size_t)row * 1024) + lane; f32x4 v[4]; float s = 0.f;
#pragma unroll
        for (int j = 0; j < 4; ++j) { v[j] = xr[64 * j]; s += (v[j].x * v[j].x + v[j].y * v[j].y) + (v[j].z * v[j].z + v[j].w * v[j].w); }
        const float rstd = rsqrtf(wave_sum(s) * (1.f / 1024.f) + 1e-6f); const int b = row >> 11;
#pragma unroll
        for (int j = 0; j < 4; ++j) { const int col = 4 * (lane + 64 * j); f32x4 y = v[j] * rstd * *(const f32x4*)(gvec + col);
            if (sc) y = y * (*(const f32x4*)(sc + (size_t)b * 6144 + col) + 1.f) + *(const f32x4*)(sh + (size_t)b * 6144 + col);
            if (outb) { u32x2 o = {pk2(y.x, y.y), pk2(y.z, y.w)}; *(u32x2*)(outb + (size_t)row * 1024 + col) = o; }
            else *(f32x4*)(outf + (size_t)row * 1024 + col) = y; }
    }
}

__device__ __forceinline__ void compress_wave(const KP& p, int l, int witem, int wv) { unsigned char* ws_ = PWS(); const int tidx_ = wv * 64 + lane_id_v();
    const int lane = tidx_ & 63, fr = lane & 15, fq = lane >> 4;
    const int ct = witem & 7, kv = (witem >> 3) & 1, g = (witem >> 4) & 1, b = witem >> 5;
    const unsigned char* wb = ws_ + WS_W + (size_t)l * W_LAYER;
    const bf16_t* src = (const bf16_t*)(ws_ + WS_NK + (size_t)kv * NKSLOT);
    const bf16_t* w1T = (const bf16_t*)(wb + (kv ? WO_PV1 : WO_PK1));
    const bf16_t* w2T = (const bf16_t*)(wb + (kv ? WO_PV2 : WO_PK2));
    const float* bias1 = (const float*)(ws_ + WS_BIAS1) + (l * 2 + kv) * 64;
    const int c = ct * 16 + fr, cc = c < 127 ? c : 126;
    const bf16_t* brow = src + (size_t)(b * 2048 + 16 * cc) * 128 + g * 64 + fq * 8;
    f32x4 acc[4];
#pragma unroll
    for (int i = 0; i < 4; ++i) acc[i] = (f32x4){0.f, 0.f, 0.f, 0.f};
#pragma unroll 8
    for (int ks = 0; ks < 64; ++ks) {
        const bf16x8 bfr = ld8(brow + (ks >> 1) * 128 + (ks & 1) * 32);
#pragma unroll
        for (int nt = 0; nt < 4; ++nt) { const bf16x8 afr = ld8(w1T + (size_t)(nt * 16 + fr) * 2048 + ks * 32 + fq * 8); acc[nt] = MFMA16(afr, bfr, acc[nt]); }
    }
#pragma unroll
    for (int nt = 0; nt < 4; ++nt) { const f32x4 bb = *(const f32x4*)(bias1 + nt * 16 + 4 * fq); f32x4 v = acc[nt] + bb; acc[nt] = (f32x4){gelu_t(v.x), gelu_t(v.y), gelu_t(v.z), gelu_t(v.w)}; }
    bf16_t* dstk = (bf16_t*)(ws_ + WS_KCMP) + ((size_t)(b * 2 + g) * 128 + c) * 64;
    bf16_t* dstv = (bf16_t*)(ws_ + WS_VCMP) + (size_t)(b * 2 + g) * 64 * 128 + c;
#pragma unroll
    for (int mt = 0; mt < 4; ++mt) { f32x4 o = (f32x4){0.f, 0.f, 0.f, 0.f};
#pragma unroll
        for (int pp = 0; pp < 2; ++pp) { const bf16_t* ar = w2T + (mt * 16 + fr) * 64 + 32 * pp + 4 * fq; o = MFMA16(ld44(ar, ar + 16), pack8(acc[2 * pp], acc[2 * pp + 1]), o); }
        if (c >= 127) o = (f32x4){0.f, 0.f, 0.f, 0.f};
        if (kv == 0) { const u32x2 w = {pk2(o.x, o.y), pk2(o.z, o.w)}; *(u32x2*)(dstk + mt * 16 + 4 * fq) = w; }
        else { bf16_t* q = dstv + (size_t)(mt * 16 + 4 * fq) * 128; q[0] = (bf16_t)f2bf(o.x); q[128] = (bf16_t)f2bf(o.y); q[256] = (bf16_t)f2bf(o.z); q[384] = (bf16_t)f2bf(o.w); } }
}

__device__ __forceinline__ void gmlp_item(const KP& p, int l, int item, unsigned char* lds, int wv, int dup, int wlds) { unsigned char* ws_ = PWS(); const int tidx_ = wv * 64 + lane_id_v();
    const int tid = tidx_, lane = tid & 63, fr = lane & 15, fq = lane >> 4, g = item & 3, ck = (item >> 2) & 15, b = item >> 6, tok0 = b * 2048 + ck * 128;
    bf16_t* VT = (bf16_t*)lds;
    const bf16_t* V = (const bf16_t*)(ws_ + WS_Z + 3 * ZSLOT); bf16_t* U = (bf16_t*)(ws_ + WS_Z); bf16_t* Uo = dup ? (bf16_t*)(ws_ + WS_GAB) : U;
    __syncthreads();
    { const int t = tid >> 2, part = tid & 3; const bf16_t* vr = V + (size_t)(tok0 + t) * 512 + part * 128; float s1 = 0.f, s2 = 0.f;
#pragma unroll
      for (int i = 0; i < 16; ++i) { const u32x4 q = *(const u32x4*)(vr + 8 * i); const float e[8] = {bf_lo(q.x), bf_hi(q.x), bf_lo(q.y), bf_hi(q.y), bf_lo(q.z), bf_hi(q.z), bf_lo(q.w), bf_hi(q.w)};
#pragma unroll
          for (int k = 0; k < 8; ++k) { s1 += e[k]; s2 += e[k] * e[k]; } }
      s1 += __shfl_xor(s1, 1); s1 += __shfl_xor(s1, 2); s2 += __shfl_xor(s2, 1); s2 += __shfl_xor(s2, 2);
      const float mu = s1 * (1.f / 512.f), var = s2 * (1.f / 512.f) - mu * mu, rstd = rsqrtf(fmaxf(var, 0.f) + 1e-6f);
      const bf16_t* vg = V + (size_t)(tok0 + t) * 512 + g * 128 + part * 32; const float* lg = PIN(7) + l * 512 + g * 128 + part * 32; const float* lb = PIN(8) + l * 512 + g * 128 + part * 32;
#pragma unroll
      for (int i = 0; i < 4; ++i) { const u32x4 q = *(const u32x4*)(vg + 8 * i); const float e[8] = {bf_lo(q.x), bf_hi(q.x), bf_lo(q.y), bf_hi(q.y), bf_lo(q.z), bf_hi(q.z), bf_lo(q.w), bf_hi(q.w)};
#pragma unroll
          for (int k = 0; k < 8; ++k) VT[(part * 32 + 8 * i + k) * 136 + t] = (bf16_t)f2bf((e[k] - mu) * rstd * lg[8 * i + k] + lb[8 * i + k]); } }
    __syncthreads();
    const float* Wg = PIN(9) + (size_t)(l * 4 + g) * 128 * 128; const float* bsg = PIN(10) + (l * 4 + g) * 128;
    u32x2 upre[8]; float bpre[8];
#pragma unroll
    for (int tt = 0; tt < 8; ++tt) { upre[tt] = *(const u32x2*)(U + (size_t)(tok0 + 16 * tt + fr) * 512 + g * 128 + 16 * wv + 4 * fq); bpre[tt] = bsg[16 * tt + fr]; }
#pragma unroll
    for (int tt = 0; tt < 8; ++tt) {
        f32x4 acc = (f32x4){0.f, 0.f, 0.f, 0.f}; const int t = 16 * tt + fr, nk = (16 * tt + 47) >> 5;
#pragma unroll 1
        for (int ks = 0; ks < nk; ++ks) { const int s0 = 32 * ks + 8 * fq;
            const bf16x8 afr = ld8(VT + (16 * wv + fr) * 136 + s0);
            if (wlds) { acc = MFMA16(afr, ld8(VT + 128 * 136 + t * 136 + s0), acc); continue; }
            const float* wp = Wg + (size_t)t * 128 + s0; f32x4 w0 = *(const f32x4*)wp, w1 = *(const f32x4*)(wp + 4);
            w0.x = s0 + 0 <= t ? w0.x : 0.f; w0.y = s0 + 1 <= t ? w0.y : 0.f; w0.z = s0 + 2 <= t ? w0.z : 0.f; w0.w = s0 + 3 <= t ? w0.w : 0.f;
            w1.x = s0 + 4 <= t ? w1.x : 0.f; w1.y = s0 + 5 <= t ? w1.y : 0.f; w1.z = s0 + 6 <= t ? w1.z : 0.f; w1.w = s0 + 7 <= t ? w1.w : 0.f;
            acc = MFMA16(afr, pack8(w0, w1), acc); }
        const size_t ix = (size_t)(tok0 + t) * 512 + g * 128 + 16 * wv + 4 * fq; const u32x2 uq = upre[tt]; const float bias = bpre[tt];
        const u32x2 ow = {pk2(bf_lo(uq.x) * (acc[0] + bias), bf_hi(uq.x) * (acc[1] + bias)), pk2(bf_lo(uq.y) * (acc[2] + bias), bf_hi(uq.y) * (acc[3] + bias))};
        *(u32x2*)(Uo + ix) = ow; }
}

__device__ __forceinline__ void gmlp_load_w(int l, int g, unsigned char* lds, int wv) {
    const int tid = wv * 64 + lane_id_v(); bf16_t* Wl = (bf16_t*)lds + 128 * 136; const float* Wg = PIN(9) + (size_t)(l * 4 + g) * 128 * 128;
    __syncthreads();
    for (int i = tid; i < 128 * 32; i += 512) { const int t = i >> 5, s0 = (i & 31) * 4; const f32x4 w = *(const f32x4*)(Wg + t * 128 + s0);
        const u32x2 o = {pk2(s0 <= t ? w.x : 0.f, s0 + 1 <= t ? w.y : 0.f), pk2(s0 + 2 <= t ? w.z : 0.f, s0 + 3 <= t ? w.w : 0.f)}; *(u32x2*)(Wl + t * 136 + s0) = o; }
    __syncthreads();
}
__device__ __forceinline__ void mlstm_item(const KP& p, int l, int item, unsigned char* lds, int wv, int dup) { unsigned char* ws_ = PWS(); const int tidx_ = wv * 64 + lane_id_v();
    const int tid = tidx_, lane = tid & 63, w = wv, fr = lane & 15, fq = lane >> 4, b = item >> 2, h = item & 3;
    bf16_t* Qs = (bf16_t*)lds; bf16_t* Ks = Qs + 64 * 136; bf16_t* Kt = Ks + 64 * 136; bf16_t* Vt = Kt + 128 * 72; bf16_t* Cb = Vt + 128 * 72; float* st = (float*)(Cb + 144 * 136); float* gwv = st + 1024 + wv * 320;
    const bf16_t* MQ = (const bf16_t*)(ws_ + WS_Z + 5 * ZSLOT); const bf16_t* MK = (const bf16_t*)(ws_ + WS_Z + 6 * ZSLOT); const bf16_t* MV = (const bf16_t*)(ws_ + WS_Z + 4 * ZSLOT);
    bf16_t* MO = (bf16_t*)(ws_ + WS_Z + 1 * ZSLOT); bf16_t* MOo = MO; const float* SM = (const float*)(ws_ + WS_SM);
    const float* cw = PIN(11) + l * 4096; const float* cb = PIN(12) + l * 1024; const float* gb = PIN(13) + l * 8; const float* ng = PIN(14) + l * 512;
    float* Wc = st + 1024 + 8 * 320 + 16;
    __syncthreads();
    for (int i = tid; i < 144 * 136 / 2; i += 512) ((unsigned*)Cb)[i] = 0u;
    for (int i = tid; i < 2 * 5 * 128; i += 512) { const int qk = i / 640, j = (i % 640) >> 7, chl = i & 127; Wc[i] = j < 4 ? cw[j * 1024 + qk * 512 + h * 128 + chl] : cb[qk * 512 + h * 128 + chl]; }
    f32x4 Cacc[8]; f32x4 Nacc = (f32x4){0.f, 0.f, 0.f, 0.f};
#pragma unroll
    for (int i = 0; i < 8; ++i) Cacc[i] = (f32x4){0.f, 0.f, 0.f, 0.f};
    float m_prev = 0.f;
    const int oct = tid >> 5, tg = tid & 31, ch = h * 128 + oct * 8, t0 = 2 * tg;
    u32x4 xq[5], xk[5], vv[2]; float gi, gf; u32x2 op[4];
#define ML_LOAD(cn) do { const int tokn = b * 2048 + (cn) * 64; \
        _Pragma("unroll") for (int jj = 0; jj < 5; ++jj) { int r = (cn) * 64 + t0 - 3 + jj; r = r < 0 ? 0 : r; \
            xq[jj] = *(const u32x4*)(MQ + (size_t)(b * 2048 + r) * 512 + ch); xk[jj] = *(const u32x4*)(MK + (size_t)(b * 2048 + r) * 512 + ch); } \
        { const bf16_t* vr = MV + (size_t)(tokn + lane) * 512 + h * 128 + w * 16; vv[0] = *(const u32x4*)vr; vv[1] = *(const u32x4*)(vr + 8); } \
        gi = SM[(size_t)(tokn + lane) * 32 + h]; gf = SM[(size_t)(tokn + lane) * 32 + 4 + h]; \
        _Pragma("unroll") for (int tt = 0; tt < 4; ++tt) op[tt] = *(const u32x2*)(MO + (size_t)(tokn + 16 * tt + fr) * 512 + h * 128 + 16 * w + 4 * fq); } while (0)
    ML_LOAD(0);
    for (int c = 0; c < 32; ++c) {
        const int tok0 = b * 2048 + c * 64;
        asm volatile("s_waitcnt lgkmcnt(0)\n\ts_barrier" ::: "memory");
        u32x2 opc[4];
#pragma unroll
        for (int tt = 0; tt < 4; ++tt) opc[tt] = op[tt];
#pragma unroll
        for (int qk = 0; qk < 2; ++qk) {
            float x[5][8];
#pragma unroll
            for (int jj = 0; jj < 5; ++jj) { const u32x4 q = qk ? xk[jj] : xq[jj]; const bool ok = (c * 64 + t0 - 3 + jj) >= 0;
                x[jj][0] = ok ? bf_lo(q.x) : 0.f; x[jj][1] = ok ? bf_hi(q.x) : 0.f; x[jj][2] = ok ? bf_lo(q.y) : 0.f; x[jj][3] = ok ? bf_hi(q.y) : 0.f;
                x[jj][4] = ok ? bf_lo(q.z) : 0.f; x[jj][5] = ok ? bf_hi(q.z) : 0.f; x[jj][6] = ok ? bf_lo(q.w) : 0.f; x[jj][7] = ok ? bf_hi(q.w) : 0.f; }
            float y0[8], y1[8];
            { const f32x4 b0 = *(const f32x4*)(Wc + (qk * 5 + 4) * 128 + oct * 8), b1 = *(const f32x4*)(Wc + (qk * 5 + 4) * 128 + oct * 8 + 4);
              y0[0] = b0.x; y0[1] = b0.y; y0[2] = b0.z; y0[3] = b0.w; y0[4] = b1.x; y0[5] = b1.y; y0[6] = b1.z; y0[7] = b1.w; }
#pragma unroll
            for (int i = 0; i < 8; ++i) y1[i] = y0[i];
#pragma unroll
            for (int j = 0; j < 4; ++j) { const f32x4 w0 = *(const f32x4*)(Wc + (qk * 5 + j) * 128 + oct * 8), w1 = *(const f32x4*)(Wc + (qk * 5 + j) * 128 + oct * 8 + 4);
                const float wt[8] = {w0.x, w0.y, w0.z, w0.w, w1.x, w1.y, w1.z, w1.w};
#pragma unroll
                for (int i = 0; i < 8; ++i) { y0[i] += wt[i] * x[j][i]; y1[i] += wt[i] * x[j + 1][i]; } }
            const float scl = qk ? 0.08838834764831845f : 1.f;
#pragma unroll
            for (int i = 0; i < 8; ++i) { y0[i] = silu_(y0[i]) * scl; y1[i] = silu_(y1[i]) * scl; }
            bf16_t* dstm = qk ? Ks : Qs;
            const u32x4 o0 = {pk2(y0[0], y0[1]), pk2(y0[2], y0[3]), pk2(y0[4], y0[5]), pk2(y0[6], y0[7])}, o1 = {pk2(y1[0], y1[1]), pk2(y1[2], y1[3]), pk2(y1[4], y1[5]), pk2(y1[6], y1[7])};
            *(u32x4*)(dstm + t0 * 136 + oct * 8) = o0; *(u32x4*)(dstm + (t0 + 1) * 136 + oct * 8) = o1;
            if (qk) {
#pragma unroll
                for (int i = 0; i < 8; ++i) *(unsigned*)(Kt + (oct * 8 + i) * 72 + t0) = pk2(y0[i], y1[i]); }
        }
        {
#pragma unroll
            for (int hh = 0; hh < 2; ++hh) { const unsigned wq[4] = {vv[hh].x, vv[hh].y, vv[hh].z, vv[hh].w};
#pragma unroll
                for (int i = 0; i < 4; ++i) { Vt[(w * 16 + hh * 8 + 2 * i) * 72 + lane] = (bf16_t)(wq[i] & 0xffffu); Vt[(w * 16 + hh * 8 + 2 * i + 1) * 72 + lane] = (bf16_t)(wq[i] >> 16); } }
        }
        const float fi = gi + gb[h], ff = gf + gb[4 + h];
        { const int cn = c < 31 ? c + 1 : 31; ML_LOAD(cn); }
        const float lf = fminf(ff, 0.f) - __logf(1.f + __expf(-fabsf(ff)));
        float bc = lf;
#pragma unroll
        for (int o = 1; o < 64; o <<= 1) { const float v = __shfl_up(bc, o); if (lane >= o) bc += v; }
        const float cc = fi - bc; float pm = cc;
#pragma unroll
        for (int o = 1; o < 64; o <<= 1) { const float v = __shfl_up(pm, o); if (lane >= o) pm = fmaxf(pm, v); }
        float wprev, m_new;
        { const float M = fmaxf(m_prev, pm), m_t = bc + M, M63 = __shfl(M, 63);
          gwv[lane] = M; gwv[64 + lane] = cc; gwv[128 + lane] = __expf(m_prev - M); gwv[192 + lane] = __expf(-m_t); gwv[256 + lane] = __expf(cc - M63);
          wprev = __builtin_bit_cast(float, __builtin_amdgcn_readfirstlane(__builtin_bit_cast(int, __expf(m_prev - M63))));
          m_new = __builtin_bit_cast(float, __builtin_amdgcn_readfirstlane(__builtin_bit_cast(int, __shfl(m_t, 63)))); }
        asm volatile("s_waitcnt lgkmcnt(0)\n\ts_barrier" ::: "memory");
        float hv[4][4];
        {
            bf16x8 cf[4], nf[4];
#pragma unroll
            for (int kk = 0; kk < 4; ++kk) { cf[kk] = ld8(Cb + (16 * w + fr) * 136 + 32 * kk + 8 * fq); nf[kk] = ld8(Cb + (128 + fr) * 136 + 32 * kk + 8 * fq); }
#pragma unroll
            for (int tt = 0; tt < 4; ++tt) {
                bf16x8 qf[4];
#pragma unroll
                for (int kk = 0; kk < 4; ++kk) qf[kk] = ld8(Qs + (16 * tt + fr) * 136 + 32 * kk + 8 * fq);
                const float Mt = gwv[16 * tt + fr], wi = gwv[128 + 16 * tt + fr], en = gwv[192 + 16 * tt + fr];
                f32x4 a = (f32x4){0.f, 0.f, 0.f, 0.f}, dn = (f32x4){0.f, 0.f, 0.f, 0.f};
#pragma unroll
                for (int kk = 0; kk < 4; ++kk) { a = MFMA16(cf[kk], qf[kk], a); dn = MFMA16(nf[kk], qf[kk], dn); }
                const float nq = __shfl(dn[0], fr);
                f32x4 Nt = a * wi; float d1 = 0.f;
                f32x4 Pt[4];
#pragma unroll
                for (int s4 = 0; s4 < 4; ++s4) {
                    if (s4 > tt) { Pt[s4] = (f32x4){0.f, 0.f, 0.f, 0.f}; continue; }
                    f32x4 sv = (f32x4){0.f, 0.f, 0.f, 0.f};
#pragma unroll
                    for (int kk = 0; kk < 4; ++kk) sv = MFMA16(ld8(Ks + (16 * s4 + fr) * 136 + 32 * kk + 8 * fq), qf[kk], sv);
#pragma unroll
                    for (int j = 0; j < 4; ++j) { const int si = 16 * s4 + 4 * fq + j, ti = 16 * tt + fr; const float cs = gwv[64 + si];
                        sv[j] = (si <= ti) ? sv[j] * __expf(cs - Mt) : 0.f; d1 += sv[j]; }
                    Pt[s4] = sv; __builtin_amdgcn_sched_barrier(0);
                }
#pragma unroll
                for (int pp = 0; pp < 2; ++pp) { if (2 * pp > tt) continue;
                    const bf16_t* vr = Vt + (16 * w + fr) * 72 + 32 * pp + 4 * fq;
                    Nt = MFMA16(ld44(vr, vr + 16), pack8(Pt[2 * pp], Pt[2 * pp + 1]), Nt); }
                d1 = fq_sum(d1);
                const float inv = 1.f / fmaxf(fabsf(d1 + wi * nq), en); float s1 = 0.f, s2 = 0.f;
#pragma unroll
                for (int j = 0; j < 4; ++j) { hv[tt][j] = Nt[j] * inv; s1 += hv[tt][j]; s2 += hv[tt][j] * hv[tt][j]; }
                s1 = fq_sum(s1); s2 = fq_sum(s2);
                if (fq == 0) { st[(w * 64 + 16 * tt + fr) * 2] = s1; st[(w * 64 + 16 * tt + fr) * 2 + 1] = s2; }
                __builtin_amdgcn_sched_barrier(0);
            }
        }
        asm volatile("s_waitcnt lgkmcnt(0)\n\ts_barrier" ::: "memory");
#pragma unroll
        for (int tt = 0; tt < 4; ++tt) { const int t = 16 * tt + fr; float S1 = 0.f, S2 = 0.f;
#pragma unroll
            for (int q = 0; q < 8; ++q) { S1 += st[(q * 64 + t) * 2]; S2 += st[(q * 64 + t) * 2 + 1]; }
            const float mu = S1 * (1.f / 128.f), var = S2 * (1.f / 128.f) - mu * mu, rstd = rsqrtf(fmaxf(var, 0.f) + 1e-6f);
            const size_t oix = (size_t)(tok0 + t) * 512 + h * 128 + 16 * w + 4 * fq; const u32x2 oq = opc[tt]; const f32x4 g4 = *(const f32x4*)(ng + h * 128 + 16 * w + 4 * fq);
            const float o0 = sigm(bf_lo(oq.x)) * (hv[tt][0] - mu) * rstd * g4.x, o1 = sigm(bf_hi(oq.x)) * (hv[tt][1] - mu) * rstd * g4.y,
                        o2 = sigm(bf_lo(oq.y)) * (hv[tt][2] - mu) * rstd * g4.z, o3 = sigm(bf_hi(oq.y)) * (hv[tt][3] - mu) * rstd * g4.w;
            const u32x2 ow = {pk2(o0, o1), pk2(o2, o3)}; *(u32x2*)(MOo + oix) = ow; }
#pragma unroll
        for (int i = 0; i < 8; ++i) Cacc[i] = Cacc[i] * wprev;
        Nacc = Nacc * wprev;
#pragma unroll
        for (int pp = 0; pp < 2; ++pp) {
            const f32x4 wla = *(const f32x4*)(gwv + 256 + 32 * pp + 8 * fq), wlb = *(const f32x4*)(gwv + 256 + 32 * pp + 8 * fq + 4);
            const float wl[8] = {wla.x, wla.y, wla.z, wla.w, wlb.x, wlb.y, wlb.z, wlb.w};
            const u32x4 vq = *(const u32x4*)(Vt + (16 * w + fr) * 72 + 32 * pp + 8 * fq);
            const u32x4 av = {pk2(bf_lo(vq.x) * wl[0], bf_hi(vq.x) * wl[1]), pk2(bf_lo(vq.y) * wl[2], bf_hi(vq.y) * wl[3]), pk2(bf_lo(vq.z) * wl[4], bf_hi(vq.z) * wl[5]), pk2(bf_lo(vq.w) * wl[6], bf_hi(vq.w) * wl[7])};
            u32x4 nv = {pk2(wl[0], wl[1]), pk2(wl[2], wl[3]), pk2(wl[4], wl[5]), pk2(wl[6], wl[7])};
            if (fr != 0) nv = (u32x4){0u, 0u, 0u, 0u};
            const bf16x8 afr = __builtin_bit_cast(bf16x8, av), nfr = __builtin_bit_cast(bf16x8, nv);
#pragma unroll
            for (int dt = 0; dt < 8; ++dt) Cacc[dt] = MFMA16(afr, ld8(Kt + (16 * dt + fr) * 72 + 32 * pp + 8 * fq), Cacc[dt]);
            Nacc = MFMA16(nfr, ld8(Kt + (16 * w + fr) * 72 + 32 * pp + 8 * fq), Nacc);
        }
#pragma unroll
        for (int dt = 0; dt < 8; ++dt)
#pragma unroll
            for (int j = 0; j < 4; ++j) Cb[(16 * w + 4 * fq + j) * 136 + 16 * dt + fr] = (bf16_t)f2bf(Cacc[dt][j]);
        if (fq == 0) Cb[128 * 136 + 16 * w + fr] = (bf16_t)f2bf(Nacc[0]);
        m_prev = m_new;
    }
    __syncthreads();
}
#ifndef FUSE_RMS
#define FUSE_RMS 0
#endif
#ifndef GSPLIT
#define GSPLIT 4
#endif
#ifndef NSA_EARLY
#define NSA_EARLY 0
#endif
#ifndef FAST_BAR
#define FAST_BAR 1
#endif
#ifndef NSA_CMP_SB
#define NSA_CMP_SB 1
#endif
#ifndef NSA_PART
#define NSA_PART 7
#endif
__device__ __forceinline__ void nsa_loadk(const bf16_t* Kb, int key0, bf16x8 (&kf)[2][2], int fr, int fq) {
#pragma unroll
    for (int s2 = 0; s2 < 2; ++s2)
#pragma unroll
        for (int kk = 0; kk < 2; ++kk) kf[s2][kk] = ld8(Kb + (size_t)(key0 + 16 * s2 + fr) * 128 + 32 * kk + 8 * fq);
}
__device__ __forceinline__ void nsa_step(const bf16_t* Kb, const bf16_t* VTb, int key0, int pk, bf16x8 (&kf)[2][2], const bf16x8 (&qf)[4][2], const float (&slope)[4],
                                         int lo, int t, bool on, float (&m)[4], float (&ls)[4], f32x4 (&Ob)[4][4], int fr, int fq) {
    bf16x8 kn[2][2], vf[4];
    nsa_loadk(Kb, pk, kn, fr, fq);
#pragma unroll
    for (int dt = 0; dt < 4; ++dt) { const bf16_t* vp = VTb + (size_t)(16 * dt + fr) * 2048 + key0 + 4 * fq; vf[dt] = ld44(vp, vp + 16); }
    const int kb = key0 + 4 * fq;
    float pen[8];
#pragma unroll
    for (int j = 0; j < 4; ++j) { const int k0 = kb + j, k1 = kb + 16 + j;
        pen[j] = (on && k0 >= lo && k0 <= t) ? 0.f : -__builtin_inff(); pen[4 + j] = (on && k1 >= lo && k1 <= t) ? 0.f : -__builtin_inff(); }
    const float tk = (float)(t - kb);
#pragma unroll
    for (int h = 0; h < 4; ++h) {
        f32x4 S0 = (f32x4){0.f, 0.f, 0.f, 0.f}, S1 = (f32x4){0.f, 0.f, 0.f, 0.f};
        S0 = MFMA16(kf[0][0], qf[h][0], S0); S0 = MFMA16(kf[0][1], qf[h][1], S0);
        S1 = MFMA16(kf[1][0], qf[h][0], S1); S1 = MFMA16(kf[1][1], qf[h][1], S1);
        const float base = -slope[h] * tk; float sc[8], mx = -1e30f;
#pragma unroll
        for (int j = 0; j < 4; ++j) {
            sc[j] = __builtin_fmaf(S0[j], 0.18033688011112042f, __builtin_fmaf(slope[h], (float)j, base)) + pen[j];
            sc[4 + j] = __builtin_fmaf(S1[j], 0.18033688011112042f, __builtin_fmaf(slope[h], (float)(16 + j), base)) + pen[4 + j];
            mx = fmaxf(mx, fmaxf(sc[j], sc[4 + j])); }
        mx = fq_max(mx);
        const float mn = fmaxf(m[h], mx), al = __builtin_amdgcn_exp2f(m[h] - mn); m[h] = mn;
        float ps = 0.f;
#pragma unroll
        for (int j = 0; j < 8; ++j) { sc[j] = __builtin_amdgcn_exp2f(sc[j] - mn); ps += sc[j]; }
        ls[h] = ls[h] * al + ps;
        const u32x4 pw = {pk2(sc[0], sc[1]), pk2(sc[2], sc[3]), pk2(sc[4], sc[5]), pk2(sc[6], sc[7])};
        const bf16x8 pf = __builtin_bit_cast(bf16x8, pw);
#pragma unroll
        for (int dt = 0; dt < 4; ++dt) { Ob[h][dt] = Ob[h][dt] * al; Ob[h][dt] = MFMA16(vf[dt], pf, Ob[h][dt]); }
        if (h & 1) __builtin_amdgcn_sched_barrier(0);
    }
#pragma unroll
    for (int s2 = 0; s2 < 2; ++s2)
#pragma unroll
        for (int kk = 0; kk < 2; ++kk) kf[s2][kk] = kn[s2][kk];
}
__device__ __forceinline__ void nsa_tile(const KP& p, int l, int witem, unsigned char* lds, int wv, int dup) {
    unsigned char* ws_ = PWS(); const int lane = lane_id_v(), fr = lane & 15, fq = lane >> 4;
    const int qt = witem & 127, g = (witem >> 7) & 1, b = witem >> 8, t0 = qt * 16, tok0 = b * 2048 + t0, t = t0 + fr, jt = t0 >> 6;
    float* ol = (float*)(lds + wv * 16384) + lane;
    bf16_t* NQ = (bf16_t*)(ws_ + WS_Z + 2 * ZSLOT); const float* gp = (const float*)(ws_ + WS_SM) + (size_t)(tok0 + fr) * 32 + 8 + g * 12;
    const bf16_t* NKb = (const bf16_t*)(ws_ + WS_NK);
    float slope[4];
#pragma unroll
    for (int h = 0; h < 4; ++h) slope[h] = exp2f(-(float)(g * 4 + h + 1));
    float impv[8];
#pragma unroll
    for (int i = 0; i < 8; ++i) impv[i] = 0.f;
    if (NSA_PART & 1) {
        const bf16_t* Kc = (const bf16_t*)(ws_ + WS_KCMP) + (size_t)(b * 2 + g) * 128 * 64; const bf16_t* VcT = (const bf16_t*)(ws_ + WS_VCMP) + (size_t)(b * 2 + g) * 64 * 128;
        const int srcl = (lane + 48) & 63;
#pragma unroll 1
        for (int h = 0; h < 4; ++h) {
            const float slope_h = exp2f(-(float)(g * 4 + h + 1));
            const bf16x8 qh0 = ld8(NQ + (size_t)(tok0 + fr) * 512 + (g * 4 + h) * 64 + 8 * fq), qh1 = ld8(NQ + (size_t)(tok0 + fr) * 512 + (g * 4 + h) * 64 + 32 + 8 * fq);
            f32x4 S[8]; float mx = -1e30f;
#pragma unroll
            for (int st = 0; st < 8; ++st) { f32x4 a = (f32x4){0.f, 0.f, 0.f, 0.f};
                if (NSA_CMP_SB && (st & 1) == 0) __builtin_amdgcn_sched_barrier(0);
                a = MFMA16(ld8(Kc + (size_t)(16 * st + fr) * 64 + 8 * fq), qh0, a); a = MFMA16(ld8(Kc + (size_t)(16 * st + fr) * 64 + 32 + 8 * fq), qh1, a);
#pragma unroll
                for (int j = 0; j < 4; ++j) { const int c = 16 * st + 4 * fq + j; const bool ok = (c < 127) && (16 * c + 31 <= t);
                    a[j] = ok ? a[j] * 0.125f - slope_h * ((float)t - (16.f * (float)c + 15.5f)) : -1e30f; mx = fmaxf(mx, a[j]); }
                S[st] = a; }
            mx = fq_max(mx);
            float sum = 0.f;
#pragma unroll
            for (int st = 0; st < 8; ++st)
#pragma unroll
                for (int j = 0; j < 4; ++j) { S[st][j] = S[st][j] > -1e29f ? __expf(S[st][j] - mx) : 0.f; sum += S[st][j]; }
            sum = fq_sum(sum);
            const float inv = sum > 0.f ? 1.f / sum : 0.f;
#pragma unroll
            for (int st = 0; st < 8; ++st) { S[st] = S[st] * inv;
                const float a3 = __shfl(S[st][3], srcl); const float b3 = st > 0 ? __shfl(S[st - 1][3], srcl) : 0.f;
                impv[st] += (S[st][0] + S[st][1]) + (S[st][2] + S[st][3]) + (fq > 0 ? a3 : b3); }
            f32x4 Oc[4];
#pragma unroll
            for (int dt = 0; dt < 4; ++dt) Oc[dt] = (f32x4){0.f, 0.f, 0.f, 0.f};
#pragma unroll
            for (int pp = 0; pp < 4; ++pp) { if (NSA_CMP_SB) __builtin_amdgcn_sched_barrier(0); const bf16x8 pf = pack8(S[2 * pp], S[2 * pp + 1]);
#pragma unroll
                for (int dt = 0; dt < 4; ++dt) { const bf16_t* vp = VcT + (size_t)(16 * dt + fr) * 128 + 32 * pp + 4 * fq; Oc[dt] = MFMA16(ld44(vp, vp + 16), pf, Oc[dt]); } }
            const float g0 = sigm(gp[h * 3 + 0]);
#pragma unroll
            for (int dt = 0; dt < 4; ++dt)
#pragma unroll
                for (int j = 0; j < 4; ++j) ol[((h * 4 + dt) * 4 + j) * 64] = g0 * Oc[dt][j];
            __builtin_amdgcn_sched_barrier(0);
        }
    }
    unsigned selq = 1u, umask = 1u;
    if (NSA_PART & 2) {
        float val[8];
#pragma unroll
        for (int st = 0; st < 8; ++st) { const int J = 4 * st + fq; val[st] = J > jt ? -1e30f : ((J == 0 || J == jt || J == jt - 1) ? 1e4f : impv[st]); }
        int rank[8];
#pragma unroll
        for (int st = 0; st < 8; ++st) rank[st] = 0;
#pragma unroll
        for (int sq = 0; sq < 4; ++sq)
#pragma unroll
            for (int s2 = 0; s2 < 8; ++s2) { const float o = __shfl(val[s2], fr + 16 * sq); const int J2 = 4 * s2 + sq;
#pragma unroll
                for (int st = 0; st < 8; ++st) { const int J = 4 * st + fq; rank[st] += (o > val[st] || (o == val[st] && J2 < J)) ? 1 : 0; } }
        unsigned mk = 0u;
#pragma unroll
        for (int st = 0; st < 8; ++st) { const int J = 4 * st + fq; if (rank[st] < 8 && J <= jt) mk |= 1u << J; }
        mk = fq_or(mk);
        selq = mk; unsigned um = mk;
        um |= __shfl_xor(um, 1); um |= __shfl_xor(um, 2); um |= __shfl_xor(um, 4); um |= __shfl_xor(um, 8);
        umask = __builtin_amdgcn_readfirstlane(um);
    }
    __builtin_amdgcn_sched_barrier(0);
#pragma unroll
    for (int h = 0; h < 4; ++h) slope[h] *= 1.4426950408889634f;
    bf16x8 qf[4][2];
#pragma unroll
    for (int h = 0; h < 4; ++h)
#pragma unroll
        for (int kk = 0; kk < 2; ++kk) qf[h][kk] = ld8(NQ + (size_t)(tok0 + fr) * 512 + (g * 4 + h) * 64 + 32 * kk + 8 * fq);
#pragma unroll 1
    for (int br = 1; br < 3; ++br) { if (!(NSA_PART & 4)) break;
        const bf16_t* Kb = NKb + (size_t)(2 * br) * ((size_t)T * 128) + (size_t)b * 2048 * 128 + g * 64;
        const bf16_t* VTb = NKb + (size_t)(2 * br + 1) * ((size_t)T * 128) + (size_t)(b * 2 + g) * 64 * 2048;
        float m[4] = {-1e30f, -1e30f, -1e30f, -1e30f}, ls[4] = {0.f, 0.f, 0.f, 0.f}; f32x4 Ob[4][4];
#pragma unroll
        for (int h = 0; h < 4; ++h)
#pragma unroll
            for (int dt = 0; dt < 4; ++dt) Ob[h][dt] = (f32x4){0.f, 0.f, 0.f, 0.f};
        {
            unsigned mk = umask; int key0;
            if (br == 1) { key0 = 64 * __builtin_ctz(mk); mk &= mk - 1; }
            else { key0 = t0 - 511; key0 = key0 < 0 ? 0 : (key0 & ~31); }
            bf16x8 kf[2][2]; nsa_loadk(Kb, key0, kf, fr, fq);
#pragma unroll 1
            while (key0 >= 0) {
                int nk;
                if (br == 1) { if ((key0 & 32) == 0 && key0 + 32 <= t0 + 15) nk = key0 + 32; else if (mk) { nk = 64 * __builtin_ctz(mk); mk &= mk - 1; } else nk = -1; }
                else nk = (key0 + 32 <= t0 + 15) ? key0 + 32 : -1;
                const bool on = br == 1 ? ((selq >> (key0 >> 6)) & 1u) : true;
                nsa_step(Kb, VTb, key0, nk >= 0 ? nk : key0, kf, qf, slope, br == 1 ? 0 : t - 511, t, on, m, ls, Ob, fr, fq);
                key0 = nk;
            }
        }
#pragma unroll
        for (int h = 0; h < 4; ++h) { float lt = ls[h]; lt = fq_sum(lt); const float sc = sigm(gp[h * 3 + br]) / lt;
#pragma unroll
            for (int dt = 0; dt < 4; ++dt) {
                if (br == 1) {
#pragma unroll
                    for (int j = 0; j < 4; ++j) ol[((h * 4 + dt) * 4 + j) * 64] += sc * Ob[h][dt][j];
                } else {
                    float o[4];
#pragma unroll
                    for (int j = 0; j < 4; ++j) o[j] = ol[((h * 4 + dt) * 4 + j) * 64] + sc * Ob[h][dt][j];
                    const u32x2 w = {pk2(o[0], o[1]), pk2(o[2], o[3])}; *(u32x2*)((dup ? (bf16_t*)(ws_ + WS_GAB) : NQ) + (size_t)(tok0 + fr) * 512 + (g * 4 + h) * 64 + 16 * dt + 4 * fq) = w;
                } } }
    }
}

#define GEMM_RUN(GB, EPI, E, Aptr, Bptr, N_, K_) do { pg8::Gemm gg{(const bf16_t*)(Aptr), (const bf16_t*)(Bptr), T, (N_), (K_)}; pg8::StaticOrder SO; SO.init(T, (N_), gdim, bid); \
    if (EN & (GB)) pg8::gemm_phase<EPI, pg8::StaticOrder, true, true>((PG8_LAS unsigned char*)lds, gg, SO, E, wv); __syncthreads(); } while (0)

#define GEMM_RUN_SUB(GB, EPI, E, Aptr, Bptr, N_, K_, G_, C_) do { pg8::Gemm gg{(const bf16_t*)(Aptr), (const bf16_t*)(Bptr), T, (N_), (K_)}; pg8::StaticOrder SO; SO.init(T, (N_), (G_), (C_)); \
    if (EN & (GB)) pg8::gemm_phase<EPI, pg8::StaticOrder, true, true>((PG8_LAS unsigned char*)lds, gg, SO, E, wv); __syncthreads(); } while (0)
#define GEMM_RUN_PANEL(GB, EPI, E, Aptr, Bptr, N_, K_) do { pg8::Gemm gg{(const bf16_t*)(Aptr), (const bf16_t*)(Bptr), T, (N_), (K_)}; PanelOrder SO{bid, (N_) / 256}; \
    if (EN & (GB)) pg8::gemm_phase<EPI, PanelOrder, true, true>((PG8_LAS unsigned char*)lds, gg, SO, E, wv); __syncthreads(); if (threadIdx.x == 0) __threadfence(); __syncthreads(); } while (0)
template <int EN> __global__ void __launch_bounds__(512, 2) mega_fwd(KP p) {
    extern __shared__ __attribute__((aligned(16))) unsigned char lds[];
    const int wv0 = __builtin_amdgcn_readfirstlane(threadIdx.x >> 6);
    if (threadIdx.x == 0) { unsigned long long* tab = (unsigned long long*)(lds + TAB_OFF);
        tab[0] = (unsigned long long)p.in[0]; tab[1] = (unsigned long long)p.in[1]; tab[2] = (unsigned long long)p.in[2]; tab[3] = (unsigned long long)p.in[3]; tab[4] = (unsigned long long)p.in[4];
        tab[5] = (unsigned long long)p.in[5]; tab[6] = (unsigned long long)p.in[6]; tab[7] = (unsigned long long)p.in[7]; tab[8] = (unsigned long long)p.in[8]; tab[9] = (unsigned long long)p.in[9];
        tab[10] = (unsigned long long)p.in[10]; tab[11] = (unsigned long long)p.in[11]; tab[12] = (unsigned long long)p.in[12]; tab[13] = (unsigned long long)p.in[13]; tab[14] = (unsigned long long)p.in[14];
        tab[15] = (unsigned long long)p.in[15]; tab[16] = (unsigned long long)p.in[16]; tab[17] = (unsigned long long)p.in[17]; tab[18] = (unsigned long long)p.in[18]; tab[19] = (unsigned long long)p.in[19];
        tab[20] = (unsigned long long)p.in[20]; tab[21] = (unsigned long long)p.in[21]; tab[22] = (unsigned long long)p.in[22]; tab[23] = (unsigned long long)p.in[23]; tab[24] = (unsigned long long)p.in[24];
        tab[25] = (unsigned long long)p.in[25]; tab[26] = (unsigned long long)p.in[26]; tab[27] = (unsigned long long)p.in[27]; tab[28] = (unsigned long long)p.out; tab[29] = (unsigned long long)p.ws; }
    const int ph_lo = p.lo, ph_hi = p.hi; unsigned nbar = 0;
    __syncthreads();
    for (int ph = ph_lo; ph < ph_hi; ++ph) {
        const int bid = blockIdx.x, gdim = gridDim.x, wv = wv0;
        const bool fuse_rms = FUSE_RMS && gdim == 256;
        if (fuse_rms && (ph == NPHASE - 1 || ph == 7 || ph == 10 || ph == 16)) continue;
        if (ph == 0) { if (EN & 1) prep_phase(p, lds, wv, bid, gdim); }
        else if (ph == NPHASE - 1) rms_phase(POUT(), PIN(27), nullptr, nullptr, nullptr, POUT(), wv, bid, gdim);
        else {
            const int l = (ph - 1) / 9, sub = (ph - 1) % 9;
#ifdef PROBE_REP
            for (int rep = 0; rep < (((PROBE_REP) >> sub) & 1) + 1; ++rep) {
#else
            {
#endif
            unsigned char* wb = PWS() + WS_W + (size_t)l * W_LAYER;
            const float* mod = (const float*)(PWS() + WS_MOD) + (size_t)l * 32 * 6144;
            const float* xin = l == 0 ? PIN(0) : POUT();
            if (sub == 0) rms_phase(xin, PIN(2) + l * 1024, mod, mod + 1024, (bf16_t*)(PWS() + WS_H), nullptr, wv, bid, gdim);
            else if (sub == 1) { EpiIn E{(bf16_t*)(PWS() + WS_Z), (bf16_t*)(PWS() + WS_NK), (float*)(PWS() + WS_SM)}; GEMM_RUN(32, EpiIn, E, PWS() + WS_H, wb + WO_IN, 4608, 1024); }
            else if (sub == 2) {
                const int dup = 0;
                if (gdim == 256) {
                    if (bid < 128) { if (EN & 2) mlstm_item(p, l, bid, lds, wv, dup); }
                    else { const int jb = bid - 128;
                        if (EN & 8) compress_wave(p, l, jb * 8 + wv, wv);
                        if (EN & 4) { gmlp_load_w(l, jb & 3, lds, wv); for (int k = 0; k < 16; ++k) gmlp_item(p, l, jb + 128 * k, lds, wv, dup, 1); } }
                } else
                for (int it = bid; it < 128 + 2048 + 128; it += gdim) {
                    if (it < 128) { if (EN & 2) mlstm_item(p, l, it, lds, wv, dup); }
                    else if (it < 128 + 2048) { if (EN & 4) gmlp_item(p, l, it - 128, lds, wv, dup, 0); }
                    else { if (EN & 8) { compress_wave(p, l, (it - 128 - 2048) * 8 + wv, wv); } }
                }
                __syncthreads();
                if (gdim == 256 && bid >= 128) {
                    EpiGate E{(bf16_t*)(PWS() + WS_GAB), (bf16_t*)(PWS() + WS_GC), 0}; GEMM_RUN_SUB(64, EpiGate, E, PWS() + WS_H, wb + WO_IN + (size_t)4608 * 1024 * 2, GSPLIT * 256, 1024, 128, bid - 128);
                    if (NSA_EARLY > 0) grid_bar((unsigned*)PWS() + 64, 128u * (unsigned)(l + 1));
                    for (int bi = bid - 128; bi < NSA_EARLY; bi += 128) nsa_tile(p, l, ((bi & ~15) | (((bi & 15) + 4 * (bi >> 8)) & 15)) * 8 + wv, lds, wv, 0);
                    __syncthreads(); }
            }
            else if (sub == 3) {
                #ifdef PROBE_DUP
                for (int dup = ((PROBE_DUP) >> 3) & 1; dup >= 0; --dup)
#else
                const int dup = 0;
#endif
                const int vb = (gdim & 7) == 0 ? (bid & 7) * (gdim >> 3) + (bid >> 3) : bid;
                if (EN & 16) for (int bi = (gdim == 256 ? NSA_EARLY : 0) + vb; bi < 1024; bi += gdim) nsa_tile(p, l, ((bi & ~15) | (((bi & 15) + 4 * (bi >> 8)) & 15)) * 8 + wv, lds, wv, dup);
                __syncthreads();
                if (gdim == 256) { EpiGate E{(bf16_t*)(PWS() + WS_GAB), (bf16_t*)(PWS() + WS_GC), GSPLIT}; GEMM_RUN(64, EpiGate, E, PWS() + WS_H, wb + WO_IN + (size_t)(4608 + GSPLIT * 256) * 1024 * 2, 3072 - GSPLIT * 256, 1024); }
                else { EpiGate E{(bf16_t*)(PWS() + WS_GAB), (bf16_t*)(PWS() + WS_GC), 0}; GEMM_RUN(64, EpiGate, E, PWS() + WS_H, wb + WO_IN + (size_t)4608 * 1024 * 2, 3072, 1024); }
            }
            else if (sub == 4) {
                { EpiUp E{(bf16_t*)(PWS() + WS_MRG), (const bf16_t*)(PWS() + WS_GAB), 1}; GEMM_RUN(128, EpiUp, E, PWS() + WS_Z, wb + WO_UPA, 1024, 512); }
                { EpiUp E{(bf16_t*)(PWS() + WS_MRG), (const bf16_t*)(PWS() + WS_GAB) + (size_t)T * 1024, 0}; GEMM_RUN(128, EpiUp, E, PWS() + WS_Z + 1 * ZSLOT, wb + WO_UPB, 1024, 512); }
                { EpiUp E{(bf16_t*)(PWS() + WS_MRG), (const bf16_t*)(PWS() + WS_GC), 0}; GEMM_RUN(128, EpiUp, E, PWS() + WS_Z + 2 * ZSLOT, wb + WO_UPC, 1024, 512); }
            }
            else if (sub == 5) { EpiRes E{xin, POUT(), mod + 2048};
                if (fuse_rms) { GEMM_RUN_PANEL(256, EpiRes, E, PWS() + WS_MRG, wb + WO_OUT, 1024, 1024);
                    rms_rows(POUT(), PIN(3) + l * 1024, mod + 3072, mod + 4096, (bf16_t*)(PWS() + WS_H), nullptr, wv, 256 * bid, 256 * bid + 256); }
                else GEMM_RUN(256, EpiRes, E, PWS() + WS_MRG, wb + WO_OUT, 1024, 1024); }
            else if (sub == 6) rms_phase(POUT(), PIN(3) + l * 1024, mod + 3072, mod + 4096, (bf16_t*)(PWS() + WS_H), nullptr, wv, bid, gdim);
            else if (sub == 7) { EpiMlp1 E{(bf16_t*)(PWS() + WS_F)}; GEMM_RUN(512, EpiMlp1, E, PWS() + WS_H, wb + WO_M1, 4096, 1024); }
            else { EpiRes E{POUT(), POUT(), mod + 5120};
                if (fuse_rms) { GEMM_RUN_PANEL(256, EpiRes, E, PWS() + WS_F, wb + WO_M2, 1024, 4096);
                    if (l == 0) { const float* mod1 = (const float*)(PWS() + WS_MOD) + (size_t)32 * 6144; rms_rows(POUT(), PIN(2) + 1024, mod1, mod1 + 1024, (bf16_t*)(PWS() + WS_H), nullptr, wv, 256 * bid, 256 * bid + 256); }
                    else rms_rows(POUT(), PIN(27), nullptr, nullptr, nullptr, POUT(), wv, 256 * bid, 256 * bid + 256); }
                else GEMM_RUN(256, EpiRes, E, PWS() + WS_F, wb + WO_M2, 1024, 4096); }
            }
        }
        if (ph + 1 < ph_hi && !(fuse_rms && ph + 1 == NPHASE - 1)) {
            if (ph == ph_lo || !FAST_BAR) cg::this_grid().sync();
            else { ++nbar; if ((gridDim.x & 7) == 0) grid_bar2((unsigned*)PWS() + 1024, nbar, (int)blockIdx.x, (int)gridDim.x); else grid_bar((unsigned*)PWS() + 128, (unsigned)gridDim.x * nbar); }
        }
    }
}

#ifndef MK_MULTI
#define MK_MULTI 0
#endif
#if MK_MULTI == 1
#define MAINK 992
#else
#define MAINK 1023
#endif
template <int EN> static void launch_plain(const KP& a, int grid, hipStream_t stream) {
    static bool attr = false;
    if (!attr) { (void)hipFuncSetAttribute((const void*)mega_fwd<EN>, hipFuncAttributeMaxDynamicSharedMemorySize, LDS_BYTES); attr = true; }
    hipLaunchKernelGGL(mega_fwd<EN>, dim3(grid), dim3(512), LDS_BYTES, stream, a);
}
extern "C" void kernel_launch(void* const* d_in, const int* in_sizes, int n_in, void* d_out, int out_size, void* d_ws, size_t ws_size, hipStream_t stream) {
    static int grid = 0;
    if (grid == 0) {
        if (n_in != 28 || out_size != T * DM || ws_size < WS_END) { fprintf(stderr, "kernel_launch: unexpected shapes n_in %d out %d ws %zu (need %zu)\n", n_in, out_size, ws_size, (size_t)WS_END); grid = -1; return; }
        int dev = 0, cus = 0, per_cu = 0;
        (void)hipGetDevice(&dev); (void)hipDeviceGetAttribute(&cus, hipDeviceAttributeMultiprocessorCount, dev);
        if (hipFuncSetAttribute((const void*)mega_fwd<MAINK>, hipFuncAttributeMaxDynamicSharedMemorySize, LDS_BYTES) != hipSuccess) { fprintf(stderr, "kernel_launch: hipFuncSetAttribute failed\n"); grid = -1; return; }
        if (hipOccupancyMaxActiveBlocksPerMultiprocessor(&per_cu, (const void*)mega_fwd<MAINK>, 512, LDS_BYTES) != hipSuccess || per_cu < 1) { fprintf(stderr, "kernel_launch: occupancy query says %d\n", per_cu); per_cu = 1; }
        (void)hipGetLastError();
        grid = cus * per_cu;
    }
    if (grid < 0) return;
    KP a{};
    for (int i = 0; i < 28; ++i) a.in[i] = (const float*)d_in[i];
    a.out = (float*)d_out; a.ws = (unsigned char*)d_ws;
#if MK_MULTI == 2
    for (int ph = 0; ph < NPHASE; ++ph) { a.lo = ph; a.hi = ph + 1; launch_plain<1023>(a, grid, stream); }
#elif MK_MULTI
    for (int ph = 0; ph < NPHASE; ++ph) { a.lo = ph; a.hi = ph + 1;
        const int sub = (ph == 0 || ph == NPHASE - 1) ? -1 : (ph - 1) % 9;
        if (ph == 0) launch_plain<1>(a, grid, stream);
        else if (sub == -1 || sub == 0 || sub == 6) launch_plain<0>(a, grid, stream);
        else if (sub == 2) { launch_plain<2>(a, grid, stream); launch_plain<4>(a, grid, stream); launch_plain<8>(a, grid, stream); }
        else if (sub == 3) { launch_plain<16>(a, grid, stream); launch_plain<992>(a, grid, stream); }
        else launch_plain<992>(a, grid, stream);
    }
#else
    a.lo = 0; a.hi = NPHASE;
    if (NSA_EARLY > 0 || FAST_BAR) (void)hipMemsetAsync(d_ws, 0, 16384, stream);
    void* args[] = {&a};
    hipError_t e = hipLaunchCooperativeKernel((const void*)mega_fwd<1023>, dim3(grid), dim3(512), args, LDS_BYTES, stream);
    if (e != hipSuccess) fprintf(stderr, "cooperative launch failed: %s (grid %d)\n", hipGetErrorString(e), grid);
#endif
}
```
